# Optimizing an MI355X kernel written in HIP

```python
import jax, jax.numpy as jnp
from jax import lax
import numpy as np

D_MODEL = 1024
BATCH = 8
SEQ = 2048
DEPTH = 2

N_MIXERS = 2
N_RGLRU_LAYERS = (DEPTH + 1) // 2
N_DSA_LAYERS = DEPTH // 2
RMS_EPS = 1e-6
ROPE_THETA = 500000.0

LRU_W = D_MODEL
LRU_BLOCKS = 16
LRU_BW = LRU_W // LRU_BLOCKS
LRU_CONV = 4
LRU_C = 8.0

ATT_HEADS = 8
ATT_HD = 128
ATT_W = ATT_HEADS * ATT_HD
ATT_ROT = ATT_HD // 4
IDX_HEADS = 8
IDX_HD = 64
IDX_ROT = IDX_HD // 4
TOPK_MAX = 256
DSA_Q_BLOCK = 32

MEM_TOKENS = 256
MEM_HEADS = 4
MEM_HD = 128
MEM_W = MEM_HEADS * MEM_HD

D_FF = 2816
FFN_CONV = 3

LRU_IN_SIZES = (LRU_W, LRU_W, MEM_W)
DSA_IN_SIZES = (ATT_W, ATT_W, ATT_W, IDX_HEADS * IDX_HD, IDX_HD, IDX_HEADS, MEM_W)
LRU_IN = sum(LRU_IN_SIZES)
DSA_IN = sum(DSA_IN_SIZES)

kernel_name = "hybrid_rglru_dsa_memxattn_convffn"


def split_cols(z, sizes):
    return jnp.split(z, [int(c) for c in np.cumsum(sizes)[:-1]], axis=-1)


def rms_norm(x, g):
    xf = x.astype(jnp.float32)
    y = xf * lax.rsqrt(jnp.mean(xf * xf, axis=-1, keepdims=True) + RMS_EPS)
    return (y * g.astype(jnp.float32)).astype(x.dtype)


def causal_dwconv(x, w, b):
    k_w = w.shape[0]
    s = x.shape[1]
    xp = jnp.pad(x, ((0, 0), (k_w - 1, 0), (0, 0)))
    y = b + xp[:, 0:s] * w[0]
    for k in range(1, k_w):
        y = y + xp[:, k:k + s] * w[k]
    return y


def rope_tables(positions, rot_dim):
    inv = ROPE_THETA ** (-jnp.arange(0, rot_dim, 2, dtype=jnp.float32) / rot_dim)
    ang = positions.astype(jnp.float32)[..., None] * inv
    return jnp.cos(ang), jnp.sin(ang)


def apply_partial_rope(x, cos, sin):
    half = cos.shape[-1]
    c = cos[:, :, None, :].astype(x.dtype)
    s = sin[:, :, None, :].astype(x.dtype)
    x1 = x[..., :half]
    x2 = x[..., half:2 * half]
    return jnp.concatenate([x1 * c - x2 * s, x2 * c + x1 * s, x[..., 2 * half:]], axis=-1)


def memory_attention(q, mem_k, mem_v):
    b, s = q.shape[0], q.shape[1]
    sc = jnp.einsum('bshd,bmhd->bhsm', q, mem_k).astype(jnp.float32) * (MEM_HD ** -0.5)
    p = jax.nn.softmax(sc, axis=-1).astype(mem_v.dtype)
    return jnp.einsum('bhsm,bmhd->bshd', p, mem_v).reshape(b, s, MEM_W)


def rglru_mixer(h, mem_k, mem_v, w_in, conv_w, conv_b, w_a, b_a, w_x, b_x, lam, w_out):
    b, s, _ = h.shape
    xb, gb, mq = split_cols(h @ w_in, LRU_IN_SIZES)
    xc = causal_dwconv(xb, conv_w, conv_b)
    xblk = xc.reshape(b, s, LRU_BLOCKS, LRU_BW)
    r = jax.nn.sigmoid(jnp.einsum('bsnc,ncd->bsnd', xblk, w_a).reshape(b, s, LRU_W) + b_a)
    i = jax.nn.sigmoid(jnp.einsum('bsnc,ncd->bsnd', xblk, w_x).reshape(b, s, LRU_W) + b_x)
    log_a = -LRU_C * r.astype(jnp.float32) * jax.nn.softplus(-lam.astype(jnp.float32))
    a = jnp.exp(log_a)
    gain = jnp.sqrt(-jnp.expm1(2.0 * log_a))
    bt = gain * (i * xc).astype(jnp.float32)

    def combine(left, right):
        a1, b1 = left
        a2, b2 = right
        return a1 * a2, a2 * b1 + b2

    _, hs = lax.associative_scan(combine, (a, bt), axis=1)
    y = hs.astype(h.dtype) * jax.nn.gelu(gb)
    m = memory_attention(mq.reshape(b, s, MEM_HEADS, MEM_HD), mem_k, mem_v)
    return jnp.concatenate([y, m], axis=-1) @ w_out


def dsa_mixer(h, cos_a, sin_a, cos_i, sin_i, mem_k, mem_v, w_in, w_out):
    b, s, _ = h.shape
    q, k, v, iq, ik, iw, mq = split_cols(h @ w_in, DSA_IN_SIZES)
    q = apply_partial_rope(q.reshape(b, s, ATT_HEADS, ATT_HD), cos_a, sin_a)
    k = apply_partial_rope(k.reshape(b, s, ATT_HEADS, ATT_HD), cos_a, sin_a)
    iq = apply_partial_rope(iq.reshape(b, s, IDX_HEADS, IDX_HD), cos_i, sin_i)
    ik = apply_partial_rope(ik[:, :, None, :], cos_i, sin_i)[:, :, 0].astype(jnp.float32)
    iw = iw * (IDX_HEADS ** -0.5)
    topk = min(TOPK_MAX, s // 4)
    n_blk = s // DSA_Q_BLOCK
    k_flat = k.reshape(b, s, ATT_W)
    v_flat = v.reshape(b, s, ATT_W)
    key_pos = jnp.arange(s)
    gather = jax.vmap(lambda arr, ix: arr[ix])

    def to_blocks(t):
        return jnp.moveaxis(t.reshape(b, n_blk, DSA_Q_BLOCK, *t.shape[2:]), 1, 0)

    def attend_block(args):
        qb, iqb, iwb, t0 = args
        qpos = t0 + jnp.arange(DSA_Q_BLOCK)
        rel = jax.nn.relu(jnp.einsum('bqhd,bsd->bqhs', iqb.astype(jnp.float32), ik) * (IDX_HD ** -0.5))
        score = jnp.einsum('bqh,bqhs->bqs', iwb.astype(jnp.float32), rel)
        causal = key_pos[None, :] <= qpos[:, None]
        score = jnp.where(causal[None], score, -jnp.inf)
        _, idx = lax.top_k(score, topk)
        valid = idx <= qpos[None, :, None]
        flat_idx = idx.reshape(b, DSA_Q_BLOCK * topk)
        ks = gather(k_flat, flat_idx).reshape(b, DSA_Q_BLOCK, topk, ATT_HEADS, ATT_HD)
        vs = gather(v_flat, flat_idx).reshape(b, DSA_Q_BLOCK, topk, ATT_HEADS, ATT_HD)
        sc = jnp.einsum('bqhd,bqkhd->bhqk', qb, ks).astype(jnp.float32) * (ATT_HD ** -0.5)
        sc = jnp.where(valid[:, None], sc, -jnp.inf)
        p = jax.nn.softmax(sc, axis=-1).astype(vs.dtype)
        return jnp.einsum('bhqk,bqkhd->bqhd', p, vs)

    out = lax.map(attend_block, (to_blocks(q), to_blocks(iq), to_blocks(iw),
                                 jnp.arange(n_blk) * DSA_Q_BLOCK))
    out = jnp.moveaxis(out, 0, 1).reshape(b, s, ATT_W)
    m = memory_attention(mq.reshape(b, s, MEM_HEADS, MEM_HD), mem_k, mem_v)
    return jnp.concatenate([out, m], axis=-1) @ w_out


def conv_ffn(h, w_up, conv_w, conv_b, w_down):
    u = causal_dwconv(h @ w_up, conv_w, conv_b)
    g, val = jnp.split(u, 2, axis=-1)
    return (jax.nn.silu(g) * val) @ w_down


def setup_inputs(seed: int = 0) -> dict:
    key = jax.random.key(seed)
    ks = jax.random.split(key, 24)
    f32 = jnp.float32

    def nrm(k, shape, fan_in):
        return jax.random.normal(k, shape, f32) * (fan_in ** -0.5)

    def gain(k, shape):
        return 1.0 + 0.01 * jax.random.normal(k, shape, f32)

    def small(k, shape):
        return 0.01 * jax.random.normal(k, shape, f32)

    x = jax.random.normal(ks[0], (BATCH, SEQ, D_MODEL), f32)
    mem = jax.random.normal(ks[1], (BATCH, MEM_TOKENS, D_MODEL), f32)
    offs = jax.random.randint(ks[2], (BATCH, 1), 0, 1024, dtype=jnp.int32)
    positions = offs + jnp.arange(SEQ, dtype=jnp.int32)[None, :]
    a_init = jax.random.uniform(ks[3], (N_RGLRU_LAYERS, LRU_W), f32, 0.9, 0.999)
    s_init = a_init ** (1.0 / LRU_C)
    lru_lambda = jnp.log(s_init) - jnp.log1p(-s_init)
    return {
        "x": x,
        "mem": mem,
        "positions": positions,
        "norm_mix": gain(ks[4], (DEPTH, D_MODEL)),
        "norm_ffn": gain(ks[5], (DEPTH, D_MODEL)),
        "mem_norm": gain(ks[6], (D_MODEL,)),
        "final_norm": gain(ks[7], (D_MODEL,)),
        "w_mem_kv": nrm(ks[8], (DEPTH, D_MODEL, 2 * MEM_W), D_MODEL),
        "w_ffn_up": nrm(ks[9], (DEPTH, D_MODEL, 2 * D_FF), D_MODEL),
        "ffn_conv_w": nrm(ks[10], (DEPTH, FFN_CONV, 2 * D_FF), FFN_CONV),
        "ffn_conv_b": small(ks[11], (DEPTH, 2 * D_FF)),
        "w_ffn_down": nrm(ks[12], (DEPTH, D_FF, D_MODEL), D_FF),
        "lru_w_in": nrm(ks[13], (N_RGLRU_LAYERS, D_MODEL, LRU_IN), D_MODEL),
        "lru_conv_w": nrm(ks[14], (N_RGLRU_LAYERS, LRU_CONV, LRU_W), LRU_CONV),
        "lru_conv_b": small(ks[15], (N_RGLRU_LAYERS, LRU_W)),
        "lru_w_a": nrm(ks[16], (N_RGLRU_LAYERS, LRU_BLOCKS, LRU_BW, LRU_BW), LRU_BW),
        "lru_b_a": small(ks[17], (N_RGLRU_LAYERS, LRU_W)),
        "lru_w_x": nrm(ks[18], (N_RGLRU_LAYERS, LRU_BLOCKS, LRU_BW, LRU_BW), LRU_BW),
        "lru_b_x": small(ks[19], (N_RGLRU_LAYERS, LRU_W)),
        "lru_lambda": lru_lambda,
        "lru_w_out": nrm(ks[20], (N_RGLRU_LAYERS, LRU_W + MEM_W, D_MODEL), LRU_W + MEM_W),
        "dsa_w_in": nrm(ks[21], (N_DSA_LAYERS, D_MODEL, DSA_IN), D_MODEL),
        "dsa_w_out": nrm(ks[22], (N_DSA_LAYERS, ATT_W + MEM_W, D_MODEL), ATT_W + MEM_W),
    }


def reference(x, mem, positions, norm_mix, norm_ffn, mem_norm, final_norm, w_mem_kv,
              w_ffn_up, ffn_conv_w, ffn_conv_b, w_ffn_down,
              lru_w_in, lru_conv_w, lru_conv_b, lru_w_a, lru_b_a, lru_w_x, lru_b_x,
              lru_lambda, lru_w_out, dsa_w_in, dsa_w_out):
    b = x.shape[0]
    cos_a, sin_a = rope_tables(positions, ATT_ROT)
    cos_i, sin_i = rope_tables(positions, IDX_ROT)
    memn = rms_norm(mem, mem_norm)
    for i in range(DEPTH):
        mk, mv = jnp.split(memn @ w_mem_kv[i], 2, axis=-1)
        mk = mk.reshape(b, MEM_TOKENS, MEM_HEADS, MEM_HD)
        mv = mv.reshape(b, MEM_TOKENS, MEM_HEADS, MEM_HD)
        hn = rms_norm(x, norm_mix[i])
        j = i // N_MIXERS
        if i % N_MIXERS == 0:
            x = x + rglru_mixer(hn, mk, mv, lru_w_in[j], lru_conv_w[j], lru_conv_b[j],
                                lru_w_a[j], lru_b_a[j], lru_w_x[j], lru_b_x[j],
                                lru_lambda[j], lru_w_out[j])
        else:
            x = x + dsa_mixer(hn, cos_a, sin_a, cos_i, sin_i, mk, mv, dsa_w_in[j], dsa_w_out[j])
        x = x + conv_ffn(rms_norm(x, norm_ffn[i]), w_ffn_up[i], ffn_conv_w[i], ffn_conv_b[i],
                         w_ffn_down[i])
    return rms_norm(x, final_norm)
```

```cpp
#include <hip/hip_runtime.h>
#include <cstdio>
#include <cstdint>
namespace pg8 {
#define PG8_LAS __attribute__((address_space(3)))
typedef unsigned short bf16_t;
typedef short bf16x8 __attribute__((ext_vector_type(8)));
typedef float f32x4 __attribute__((ext_vector_type(4)));
typedef unsigned u32x4 __attribute__((ext_vector_type(4)));
constexpr int BM = 256, BK = 64, HALF = 128, HTB = HALF * BK * 2  , STAGE_BYTES = 8 * HTB, NXCD = 8, WGM = 8;

__host__ __device__ __forceinline__ int lds_byte(int r, int c) { const int st = (r >> 4) * 2 + (c >> 5), rr = r & 15, cc = c & 31, ob = rr * 64 + cc * 2; return st * 1024 + (ob ^ (((ob >> 9) & 1) << 5)); }
__host__ __device__ __forceinline__ void stage_rc(int b, int& R, int& C) { const int st = b / 1024, sb = b % 1024, swz = sb ^ (((sb >> 9) & 1) << 5); R = (st >> 1) * 16 + swz / 64; C = (st & 1) * 32 + (swz % 64) / 2; }
__host__ __device__ __forceinline__ int perm32(int rho) { const int n = rho >> 4, i = rho & 15; return 8 * (i >> 2) + 4 * n + (i & 3); }

struct Unit { int pm, pn; };
struct Gemm { const bf16_t* A; const bf16_t* Bt; int M, N, K; };

struct StaticOrder {
    int nM, nN, nwg, G, c;
    __host__ __device__ void init(int M, int N, int G_, int c_) { nM = M / BM; nN = N / BM; nwg = nM * nN; G = G_; c = c_; }
    __host__ __device__ bool next(int i, Unit& u) const {
        const long L = (long)i * G + c; if (L >= nwg) return false;
        int wgid = (int)L; { const int q = nwg / NXCD, r = nwg % NXCD, xcd = wgid % NXCD, off = wgid / NXCD; wgid = (xcd < r ? xcd * (q + 1) : r * (q + 1) + (xcd - r) * q) + off; }
        const int nig = WGM * nN, gid = wgid / nig, fm = gid * WGM, gsz = (nM - fm) < WGM ? (nM - fm) : WGM;
        u.pm = fm + ((wgid % nig) % gsz); u.pn = (wgid % nig) / gsz; return true;
    }
    __device__ __forceinline__ void a_ready(const Unit&) const {}
    __device__ __forceinline__ void done(const Unit&) const {}
};

__device__ __forceinline__ unsigned cvt_pk_bf16(float lo, float hi) { unsigned r; asm volatile("v_cvt_pk_bf16_f32 %0, %1, %2" : "=v"(r) : "v"(lo), "v"(hi)); return r; }

template <class Epi, class Sched, bool ALIGN_EPI = false, bool SP2 = false>
__device__ __forceinline__ void gemm_phase(PG8_LAS unsigned char* lds, const Gemm g, const Sched& S, const Epi& E) {
    int tid_ = threadIdx.x; asm volatile("" : "+v"(tid_));
    const int tid = tid_, wid = __builtin_amdgcn_readfirstlane(tid >> 6), lane = tid & 63, wr = wid >> 2, wc = wid & 3, fr = lane & 15, fq = lane >> 4;
    const int K = g.K, nt = K / BK;
    unsigned voffA[2], voffB[2];
#pragma unroll
    for (int i = 0; i < 2; ++i) { int R, C; stage_rc(tid * 16 + i * 8192, R, C); const int Rb = Epi::PERM ? ((R & ~31) + perm32(R & 31)) : R;
        voffA[i] = (unsigned)(R * K + C) * 2u; voffB[i] = (unsigned)(Rb * K + C) * 2u; }
    const size_t kstep = (size_t)(BK * 2);
    const size_t hstep = (size_t)HALF * K * 2;
    const size_t tstep = 2 * hstep;
    const unsigned ldsw = (unsigned)wid * 1024u;
    const int aoff = lds_byte(wr * 64 + fr, fq * 8), boff = lds_byte(wc * 32 + fr, fq * 8);
#define PG8_SA(b, h) (((b) * 2 + (h)) * HTB)
#define PG8_SB(b, h) ((4 + (b) * 2 + (h)) * HTB)
#define PG8_STAGE(bufoff, gbase, voff) do { _Pragma("unroll") for (int _i = 0; _i < 2; ++_i) \
        __builtin_amdgcn_global_load_lds((const unsigned*)((const char*)(gbase) + (voff)[_i]), (PG8_LAS unsigned*)(lds + (bufoff) + ldsw + _i * 8192), 16, 0, 0); } while (0)
#define PG8_LDA(dst, b, h) do { _Pragma("unroll") for (int m = 0; m < 4; ++m) _Pragma("unroll") for (int k = 0; k < 2; ++k) dst[m][k] = *(const PG8_LAS bf16x8*)(lds + PG8_SA(b, h) + aoff + m * 2048 + k * 1024); } while (0)
#define PG8_LDB(dst, b, h) do { _Pragma("unroll") for (int n = 0; n < 2; ++n) _Pragma("unroll") for (int k = 0; k < 2; ++k) dst[n][k] = *(const PG8_LAS bf16x8*)(lds + PG8_SB(b, h) + boff + n * 2048 + k * 1024); } while (0)
#define PG8_MMA(ai, bj, At, Bt) do { __builtin_amdgcn_s_setprio(1); _Pragma("unroll") for (int m = 0; m < 4; ++m) _Pragma("unroll") for (int n = 0; n < 2; ++n) _Pragma("unroll") for (int k = 0; k < 2; ++k) \
        acc[ai][bj][m][n] = __builtin_amdgcn_mfma_f32_16x16x32_bf16(Bt[n][k], At[m][k], acc[ai][bj][m][n], 0, 0, 0); __builtin_amdgcn_s_setprio(0); } while (0)
#define PG8_WAIT_V(n) asm volatile("s_waitcnt vmcnt(" #n ")" ::: "memory")
#define PG8_WAIT_L(n) asm volatile("s_waitcnt lgkmcnt(" #n ")" ::: "memory")
#define PG8_BAR __builtin_amdgcn_s_barrier()
#define PG8_SCHED __builtin_amdgcn_sched_barrier(0)
    Unit cur, nxt; int ui = 0;
    if (!S.next(0, cur)) return;
    f32x4 acc[2][2][4][2];
#pragma unroll
    for (int a = 0; a < 2; ++a)
#pragma unroll
        for (int b = 0; b < 2; ++b)
#pragma unroll
            for (int m = 0; m < 4; ++m)
#pragma unroll
                for (int n = 0; n < 2; ++n) acc[a][b][m][n] = (f32x4){0.f, 0.f, 0.f, 0.f};
    bf16x8 At[4][2], B0[2][2], B1[2][2];
    const char* cA = (const char*)g.A + (size_t)cur.pm * tstep; const char* cB = (const char*)g.Bt + (size_t)cur.pn * tstep;
    S.a_ready(cur);
    if constexpr (SP2) {
        PG8_STAGE(PG8_SB(0, 0), cB, voffB); PG8_STAGE(PG8_SB(0, 1), cB + hstep, voffB); PG8_STAGE(PG8_SA(0, 0), cA, voffA); PG8_STAGE(PG8_SA(0, 1), cA + hstep, voffA);
        if (wr == 1) PG8_BAR;
        PG8_WAIT_V(2); PG8_BAR;
        PG8_STAGE(PG8_SB(1, 0), cB + kstep, voffB); PG8_STAGE(PG8_SA(1, 0), cA + kstep, voffA); PG8_STAGE(PG8_SB(1, 1), cB + hstep + kstep, voffB);
        PG8_WAIT_V(6); PG8_BAR;
    } else {
        PG8_STAGE(PG8_SB(0, 0), cB, voffB); PG8_STAGE(PG8_SA(0, 0), cA, voffA); PG8_STAGE(PG8_SB(0, 1), cB + hstep, voffB); PG8_STAGE(PG8_SA(0, 1), cA + hstep, voffA);
        if (wr == 1) PG8_BAR;
        PG8_WAIT_V(4); PG8_BAR;
        PG8_STAGE(PG8_SB(1, 0), cB + kstep, voffB); PG8_STAGE(PG8_SA(1, 0), cA + kstep, voffA); PG8_STAGE(PG8_SB(1, 1), cB + hstep + kstep, voffB);
        PG8_WAIT_V(6); PG8_BAR;
    }
    for (;;) {
        const bool has_next = S.next(ui + 1, nxt);
        const char* nA = has_next ? (const char*)g.A + (size_t)nxt.pm * tstep : cA; const char* nB = has_next ? (const char*)g.Bt + (size_t)nxt.pn * tstep : cB;
        for (int t = 0; t < nt; t += 2) {
            const bool last = (t == nt - 2);
            const char* a1 = cA + (size_t)(t + 1) * kstep;
            const char* a2 = last ? nA : cA + (size_t)(t + 2) * kstep; const char* b2 = last ? nB : cB + (size_t)(t + 2) * kstep;
            const char* a3 = a2 + kstep; const char* b3 = b2 + kstep;
            if (last && has_next) S.a_ready(nxt);
            if constexpr (SP2) {
            PG8_LDB(B0, 0, 0); PG8_LDB(B1, 0, 1); PG8_SCHED; PG8_LDA(At, 0, 0); PG8_STAGE(PG8_SA(1, 1), a1 + hstep, voffA);
            PG8_WAIT_V(8); PG8_WAIT_L(0); PG8_BAR; PG8_MMA(0, 0, At, B0); PG8_MMA(0, 1, At, B1); PG8_BAR; PG8_SCHED;
            PG8_LDA(At, 0, 1); PG8_STAGE(PG8_SB(0, 0), b2, voffB); PG8_STAGE(PG8_SB(0, 1), b2 + hstep, voffB); PG8_STAGE(PG8_SA(0, 0), a2, voffA);
            PG8_WAIT_V(8); PG8_WAIT_L(0); PG8_BAR; PG8_MMA(1, 0, At, B0); PG8_MMA(1, 1, At, B1); PG8_BAR; PG8_SCHED;
            PG8_LDB(B0, 1, 0); PG8_LDB(B1, 1, 1); PG8_SCHED; PG8_LDA(At, 1, 0); PG8_STAGE(PG8_SA(0, 1), a2 + hstep, voffA);
            PG8_WAIT_V(8); PG8_WAIT_L(0); PG8_BAR; PG8_MMA(0, 0, At, B0); PG8_MMA(0, 1, At, B1); PG8_BAR; PG8_SCHED;
            PG8_LDA(At, 1, 1); PG8_STAGE(PG8_SB(1, 0), b3, voffB); PG8_STAGE(PG8_SB(1, 1), b3 + hstep, voffB); PG8_STAGE(PG8_SA(1, 0), a3, voffA);
            PG8_WAIT_V(8); PG8_WAIT_L(0); PG8_BAR; PG8_MMA(1, 0, At, B0); PG8_MMA(1, 1, At, B1); PG8_BAR; PG8_SCHED;
            } else {
            PG8_LDB(B0, 0, 0); PG8_SCHED; PG8_LDA(At, 0, 0); PG8_STAGE(PG8_SA(1, 1), a1 + hstep, voffA);
            PG8_WAIT_L(8); PG8_BAR; PG8_WAIT_L(0); PG8_MMA(0, 0, At, B0); PG8_BAR; PG8_SCHED;
            PG8_LDB(B1, 0, 1); PG8_STAGE(PG8_SB(0, 0), b2, voffB);
            PG8_BAR; PG8_WAIT_L(0); PG8_MMA(0, 1, At, B1); PG8_BAR;
            PG8_LDA(At, 0, 1); PG8_STAGE(PG8_SA(0, 0), a2, voffA);
            PG8_BAR; PG8_WAIT_L(0); PG8_MMA(1, 0, At, B0); PG8_BAR; PG8_SCHED;
            PG8_STAGE(PG8_SB(0, 1), b2 + hstep, voffB);
            PG8_WAIT_V(6); PG8_BAR; PG8_MMA(1, 1, At, B1); PG8_BAR;
            PG8_LDB(B0, 1, 0); PG8_SCHED; PG8_LDA(At, 1, 0); PG8_STAGE(PG8_SA(0, 1), a2 + hstep, voffA);
            PG8_WAIT_L(8); PG8_BAR; PG8_WAIT_L(0); PG8_MMA(0, 0, At, B0); PG8_BAR; PG8_SCHED;
            PG8_LDB(B1, 1, 1); PG8_STAGE(PG8_SB(1, 0), b3, voffB);
            PG8_BAR; PG8_WAIT_L(0); PG8_MMA(0, 1, At, B1); PG8_BAR;
            PG8_LDA(At, 1, 1); PG8_STAGE(PG8_SA(1, 0), a3, voffA);
            PG8_BAR; PG8_WAIT_L(0); PG8_MMA(1, 0, At, B0); PG8_BAR; PG8_SCHED;
            PG8_STAGE(PG8_SB(1, 1), b3 + hstep, voffB);
            PG8_WAIT_V(6); PG8_BAR; PG8_MMA(1, 1, At, B1); PG8_BAR;
            }
        }
        if constexpr (ALIGN_EPI) { if (wr == 0) PG8_BAR; }
        if constexpr (!Epi::AFTER_DRAIN) { E(acc, cur, wr, wc, fr, fq); S.done(cur); }
        if (!has_next) break;
#pragma unroll
        for (int a = 0; a < 2; ++a)
#pragma unroll
            for (int b = 0; b < 2; ++b)
#pragma unroll
                for (int m = 0; m < 4; ++m)
#pragma unroll
                    for (int n = 0; n < 2; ++n) acc[a][b][m][n] = (f32x4){0.f, 0.f, 0.f, 0.f};
        cur = nxt; cA = nA; cB = nB; ++ui;
        if constexpr (ALIGN_EPI) { if (wr == 1) PG8_BAR; }
    }
    PG8_WAIT_V(0);
    if constexpr (!ALIGN_EPI) { if (wr == 0) PG8_BAR; }
    PG8_BAR;
    if constexpr (Epi::AFTER_DRAIN) { E.fused(acc, cur, wr, wc, fr, fq, lds, wid, lane); S.done(cur); }
#undef PG8_SA
#undef PG8_SB
#undef PG8_STAGE
#undef PG8_LDA
#undef PG8_LDB
#undef PG8_MMA
#undef PG8_WAIT_V
#undef PG8_WAIT_L
#undef PG8_BAR
#undef PG8_SCHED
}
}
namespace pg8 {
__device__ __forceinline__ unsigned bf1(float x) { return cvt_pk_bf16(x, x) & 0xffffu; }
constexpr float RMS_EPS = 1e-6f;
__device__ __forceinline__ float rstd4(const float* ssp, int row) {
    const f32x4 q = *(const f32x4*)(ssp + (unsigned)(row * 4));
    const float s = (q[0] + q[1]) + (q[2] + q[3]);
    return 1.0f / sqrtf(s * (1.0f / 1024.0f) + RMS_EPS);
}
template <int CTRL> __device__ __forceinline__ float dppf(float old, float src) {
    return __builtin_bit_cast(float, __builtin_amdgcn_update_dpp(__builtin_bit_cast(int, old), __builtin_bit_cast(int, src), CTRL, 0xf, 0xf, false));
}

struct EpiKV {
    static constexpr bool PERM = true, AFTER_DRAIN = false;
    const float* ssm;
    bf16_t* MK;
    bf16_t* MVT;
    __device__ __forceinline__ void operator()(const f32x4 (&acc)[2][2][4][2], const Unit& u, int wr, int wc, int fr_, int fq_) const {
        int fr = fr_, fq = fq_; asm volatile("" : "+v"(fr), "+v"(fq));
        const int l = u.pn >> 2, p4 = u.pn & 3;
        const int row0 = u.pm * BM + wr * 64 + fr, cl0 = wc * 32 + 8 * fq;
#pragma unroll
        for (int ai = 0; ai < 2; ++ai)
#pragma unroll
            for (int m = 0; m < 4; ++m) {
                const int row = row0 + ai * HALF + m * 16;
                const float rs = 1.0f / sqrtf(ssm[row] * (1.0f / 1024.0f) + RMS_EPS);
                if (p4 < 2) {
                    bf16_t* rowp = MK + ((size_t)l * 2048 + row) * 512 + p4 * 256 + cl0;
#pragma unroll
                    for (int bj = 0; bj < 2; ++bj) { const f32x4 v0 = acc[ai][bj][m][0] * rs, v1 = acc[ai][bj][m][1] * rs;
                        u32x4 w; w.x = cvt_pk_bf16(v0[0], v0[1]); w.y = cvt_pk_bf16(v0[2], v0[3]); w.z = cvt_pk_bf16(v1[0], v1[1]); w.w = cvt_pk_bf16(v1[2], v1[3]);
                        *(u32x4*)(rowp + bj * HALF) = w; }
                } else {
                    const int b = row >> 8, key = row & 255;
#pragma unroll
                    for (int bj = 0; bj < 2; ++bj)
#pragma unroll
                        for (int n = 0; n < 2; ++n)
#pragma unroll
                            for (int j = 0; j < 4; ++j) { const int c = (p4 - 2) * 256 + bj * HALF + cl0 + 4 * n + j, h = c >> 7, d = c & 127;
                                MVT[((((size_t)l * 8 + b) * 4 + h) * 128 + d) * 256 + key] = (bf16_t)bf1(acc[ai][bj][m][n][j] * rs); }
                }
            }
    }
};

struct EpiIn0 {
    static constexpr bool PERM = true, AFTER_DRAIN = false;
    const float* ssp; bf16_t *XBR, *GBR, *CAT;
    __device__ __forceinline__ void operator()(const f32x4 (&acc)[2][2][4][2], const Unit& u, int wr, int wc, int fr_, int fq_) const {
        int fr = fr_, fq = fq_; asm volatile("" : "+v"(fr), "+v"(fq));
        const int seg = u.pn >> 2; bf16_t* base; int pitch, colt;
        if (seg == 0) { base = XBR; pitch = 1024; colt = u.pn * 256; } else if (seg == 1) { base = GBR; pitch = 1024; colt = (u.pn - 4) * 256; } else { base = CAT + 1024; pitch = 1536; colt = (u.pn - 8) * 256; }
        const int row0 = u.pm * BM + wr * 64 + fr, col0 = colt + wc * 32 + 8 * fq;
#pragma unroll
        for (int ai = 0; ai < 2; ++ai)
#pragma unroll
            for (int m = 0; m < 4; ++m) { const int row = row0 + ai * HALF + m * 16; const float rs = rstd4(ssp, row);
                bf16_t* rowp = base + (size_t)row * pitch + col0;
#pragma unroll
                for (int bj = 0; bj < 2; ++bj) { const f32x4 v0 = acc[ai][bj][m][0] * rs, v1 = acc[ai][bj][m][1] * rs;
                    u32x4 w; w.x = cvt_pk_bf16(v0[0], v0[1]); w.y = cvt_pk_bf16(v0[2], v0[3]); w.z = cvt_pk_bf16(v1[0], v1[1]); w.w = cvt_pk_bf16(v1[2], v1[3]);
                    *(u32x4*)(rowp + bj * HALF) = w; } }
    }
};

struct EpiOut {
    static constexpr bool PERM = false, AFTER_DRAIN = true;
    const float* base; float* out; bf16_t* xb16; float* ssp;
    __device__ __forceinline__ void fused(f32x4 (&acc)[2][2][4][2], const Unit& u, int wr, int wc, int fr, int fq, PG8_LAS unsigned char* lds, int wid, int lane) const {
        typedef unsigned u32x2v __attribute__((ext_vector_type(2)));
        PG8_LAS float* P = (PG8_LAS float*)lds;
        const int col0 = u.pn * BM + wc * 32 + 4 * fq;
#pragma unroll
        for (int ai = 0; ai < 2; ++ai)
#pragma unroll
            for (int m = 0; m < 4; ++m) { const int r = ai * HALF + wr * 64 + m * 16 + fr; const size_t off = (size_t)(u.pm * BM + r) * 1024 + col0; float ss = 0.f;
#pragma unroll
                for (int bj = 0; bj < 2; ++bj)
#pragma unroll
                    for (int n = 0; n < 2; ++n) { const f32x4 bs = *(const f32x4*)(base + off + bj * HALF + n * 16); const f32x4 v = bs + acc[ai][bj][m][n];
                        *(f32x4*)(out + off + bj * HALF + n * 16) = v; ss += (v[0] * v[0] + v[1] * v[1]) + (v[2] * v[2] + v[3] * v[3]);
                        u32x2v w; w.x = cvt_pk_bf16(v[0], v[1]); w.y = cvt_pk_bf16(v[2], v[3]); *(u32x2v*)(xb16 + off + bj * HALF + n * 16) = w; }
                ss += __shfl_xor(ss, 16); ss += __shfl_xor(ss, 32);
                if (fq == 0) P[r * 4 + wc] = ss;
                asm volatile("" ::: "memory"); }
        asm volatile("s_waitcnt lgkmcnt(0)" ::: "memory"); __builtin_amdgcn_s_barrier(); asm volatile("" ::: "memory");
        const int tid = wid * 64 + lane;
        if (tid < 256) ssp[(size_t)(u.pm * BM + tid) * 4 + u.pn] = (P[tid * 4 + 0] + P[tid * 4 + 1]) + (P[tid * 4 + 2] + P[tid * 4 + 3]);
        asm volatile("s_waitcnt lgkmcnt(0)" ::: "memory"); __builtin_amdgcn_s_barrier(); asm volatile("" ::: "memory");
    }
};

struct EpiUp {
    static constexpr bool PERM = true, AFTER_DRAIN = false;
    const float* ssp; const float* cw; const float* cb; bf16_t* ACT; float* HALO;
    __device__ __forceinline__ void operator()(const f32x4 (&acc)[2][2][4][2], const Unit& u, int wr, int wc, int fr_, int fq_) const {
        int fr = fr_, fq = fq_; asm volatile("" : "+v"(fr), "+v"(fq));
        const int chb = u.pn * 128 + wc * 32 + 8 * fq;
        const int row0 = u.pm * BM + wr * 64 + fr;
        float rs[2][4];
#pragma unroll
        for (int ai = 0; ai < 2; ++ai) {
#pragma unroll
            for (int m = 0; m < 4; ++m) rs[ai][m] = rstd4(ssp, row0 + ai * HALF + m * 16);
            asm volatile("" : "+v"(rs[ai][0]), "+v"(rs[ai][1]), "+v"(rs[ai][2]), "+v"(rs[ai][3]));
            __builtin_amdgcn_sched_barrier(0); }
#pragma unroll
        for (int n = 0; n < 2; ++n)
#pragma unroll
            for (int jp = 0; jp < 2; ++jp) {
                const unsigned uc = (unsigned)(chb + 4 * n + 2 * jp);
                float wg[2][4], wv[2][4];
#pragma unroll
                for (int jj = 0; jj < 2; ++jj) {
                    wg[jj][0] = cw[uc + jj]; wg[jj][1] = cw[uc + jj + 5632u]; wg[jj][2] = cw[uc + jj + 2u * 5632u]; wg[jj][3] = cb[uc + jj];
                    wv[jj][0] = cw[uc + jj + 2816u]; wv[jj][1] = cw[uc + jj + 5632u + 2816u]; wv[jj][2] = cw[uc + jj + 2u * 5632u + 2816u]; wv[jj][3] = cb[uc + jj + 2816u]; }
#pragma unroll
                for (int ai = 0; ai < 2; ++ai) {
                    const int chunk = u.pm * 4 + ai * 2 + wr;
                    float res[4][2];
#pragma unroll
                    for (int jj = 0; jj < 2; ++jj) {
                        const int j = 2 * jp + jj;
                        float ug[4], uv[4];
#pragma unroll
                        for (int m = 0; m < 4; ++m) { ug[m] = acc[ai][0][m][n][j] * rs[ai][m]; uv[m] = acc[ai][1][m][n][j] * rs[ai][m]; }
                        if (fr < 2) { float* hp = HALO + (unsigned)((chunk * 4 + fr) * 2 * 2816) + (uc + jj); hp[0] = ug[0]; hp[2816] = uv[0]; }
                        if (fr >= 14) { float* hp = HALO + (unsigned)((chunk * 4 + (fr - 12)) * 2 * 2816) + (uc + jj); hp[0] = ug[3]; hp[2816] = uv[3]; }
#pragma unroll
                        for (int m = 0; m < 4; ++m) {
                            float og1 = 0.f, og2 = 0.f, ov1 = 0.f, ov2 = 0.f;
                            if (m > 0) { og1 = dppf<0x121>(0.f, ug[m - 1]); og2 = dppf<0x122>(0.f, ug[m - 1]); ov1 = dppf<0x121>(0.f, uv[m - 1]); ov2 = dppf<0x122>(0.f, uv[m - 1]); }
                            const float g1 = dppf<0x111>(og1, ug[m]), g2 = dppf<0x112>(og2, ug[m]), v1 = dppf<0x111>(ov1, uv[m]), v2 = dppf<0x112>(ov2, uv[m]);
                            const float yg = wg[jj][3] + wg[jj][0] * g2 + wg[jj][1] * g1 + wg[jj][2] * ug[m];
                            const float yv = wv[jj][3] + wv[jj][0] * v2 + wv[jj][1] * v1 + wv[jj][2] * uv[m];
                            res[m][jj] = yg * __builtin_amdgcn_rcpf(1.0f + __expf(-yg)) * yv;
                        }
                    }
#pragma unroll
                    for (int m = 0; m < 4; ++m)
                        if (m > 0 || fr >= 2) *(unsigned*)(ACT + (unsigned)((row0 + ai * HALF + m * 16) * 2816) + uc) = cvt_pk_bf16(res[m][0], res[m][1]);
                    __builtin_amdgcn_sched_barrier(0);
                }
            }
    }
};

struct EpiIn1 {
    static constexpr bool PERM = false, AFTER_DRAIN = false;
    const float* ssp; const float *cosA, *sinA, *cosI, *sinI;
    bf16_t *CAT, *KB, *VT, *IQ, *IK; float* IW;
    __device__ __forceinline__ void operator()(const f32x4 (&acc)[2][2][4][2], const Unit& u, int wr, int wc, int fr_, int fq_) const {
        typedef unsigned u32x2v __attribute__((ext_vector_type(2)));
        int fr = fr_, fq = fq_; asm volatile("" : "+v"(fr), "+v"(fq));
        const int pn = u.pn;
        const int row0 = u.pm * BM + wr * 64 + fr;
#pragma unroll
        for (int ai = 0; ai < 2; ++ai)
#pragma unroll
            for (int m = 0; m < 4; ++m) {
                const int row = row0 + ai * HALF + m * 16; const float rs = rstd4(ssp, row);
                f32x4 v[2][2];
#pragma unroll
                for (int bj = 0; bj < 2; ++bj)
#pragma unroll
                    for (int n = 0; n < 2; ++n) v[bj][n] = acc[ai][bj][m][n] * rs;
                if (pn < 8) {
                    if (wc == 0) { const f32x4 c = *(const f32x4*)(cosA + (size_t)row * 16 + 4 * fq), s = *(const f32x4*)(sinA + (size_t)row * 16 + 4 * fq);
#pragma unroll
                        for (int bj = 0; bj < 2; ++bj) { const f32x4 x1 = v[bj][0], x2 = v[bj][1]; v[bj][0] = x1 * c - x2 * s; v[bj][1] = x2 * c + x1 * s; } }
                    bf16_t* rowp = (pn < 4) ? CAT + (size_t)row * 1536 + pn * 256 : KB + (size_t)row * 1024 + (pn - 4) * 256;
#pragma unroll
                    for (int bj = 0; bj < 2; ++bj)
#pragma unroll
                        for (int n = 0; n < 2; ++n) { u32x2v w; w.x = cvt_pk_bf16(v[bj][n][0], v[bj][n][1]); w.y = cvt_pk_bf16(v[bj][n][2], v[bj][n][3]);
                            *(u32x2v*)(rowp + bj * HALF + wc * 32 + n * 16 + 4 * fq) = w; }
                } else if (pn < 12) {
                    const int b = row >> 11, s = row & 2047;
#pragma unroll
                    for (int bj = 0; bj < 2; ++bj) { const int head = (pn - 8) * 2 + bj;
#pragma unroll
                        for (int n = 0; n < 2; ++n)
#pragma unroll
                            for (int j = 0; j < 4; ++j) { const int d = wc * 32 + n * 16 + 4 * fq + j;
                                VT[(((size_t)b * 8 + head) * 128 + d) * 2048 + s] = (bf16_t)bf1(v[bj][n][j]); } }
                } else if (pn < 14) {
                    bf16_t* rowp = CAT + (size_t)row * 1536 + 1024 + (pn - 12) * 256;
#pragma unroll
                    for (int bj = 0; bj < 2; ++bj)
#pragma unroll
                        for (int n = 0; n < 2; ++n) { u32x2v w; w.x = cvt_pk_bf16(v[bj][n][0], v[bj][n][1]); w.y = cvt_pk_bf16(v[bj][n][2], v[bj][n][3]);
                            *(u32x2v*)(rowp + bj * HALF + wc * 32 + n * 16 + 4 * fq) = w; }
                } else {
                    if ((wc & 1) == 0 && !(pn == 16 && wc >= 2)) { const int fi = 4 * (fq & 1);
                        const f32x4 c = *(const f32x4*)(cosI + (size_t)row * 8 + fi), s = *(const f32x4*)(sinI + (size_t)row * 8 + fi);
#pragma unroll
                        for (int bj = 0; bj < 2; ++bj) { f32x4 p;
#pragma unroll
                            for (int j = 0; j < 4; ++j) p[j] = __shfl_xor(v[bj][0][j], 32);
                            v[bj][0] = (fq < 2) ? (v[bj][0] * c - p * s) : (v[bj][0] * c + p * s); } }
                    if (pn < 16) { bf16_t* rowp = IQ + (size_t)row * 512 + (pn - 14) * 256;
#pragma unroll
                        for (int bj = 0; bj < 2; ++bj)
#pragma unroll
                            for (int n = 0; n < 2; ++n) { u32x2v w; w.x = cvt_pk_bf16(v[bj][n][0], v[bj][n][1]); w.y = cvt_pk_bf16(v[bj][n][2], v[bj][n][3]);
                                *(u32x2v*)(rowp + bj * HALF + wc * 32 + n * 16 + 4 * fq) = w; }
                    } else {
                        if (wc < 2) {
#pragma unroll
                            for (int n = 0; n < 2; ++n) { u32x2v w; w.x = cvt_pk_bf16(v[0][n][0], v[0][n][1]); w.y = cvt_pk_bf16(v[0][n][2], v[0][n][3]);
                                *(u32x2v*)(IK + (size_t)row * 64 + wc * 32 + n * 16 + 4 * fq) = w; }
                        } else if (wc == 2 && fq < 2) { *(f32x4*)(IW + (size_t)row * 8 + 4 * fq) = v[0][0] * 0.35355339059327373f; }
                    }
                }
                __builtin_amdgcn_sched_barrier(0);
            }
    }
};
}
constexpr int NWAVES = 8;
#ifndef MK_N_LAUNCHES
#define MK_N_LAUNCHES 1
#endif
constexpr int N_PHASES = 15;
constexpr int NB = 8, SEQ = 2048, DM = 1024, M = NB * SEQ, MEMT = 256, MMEM = NB * MEMT;
constexpr int DFF = 2816, NUP = 2 * DFF, NIN0 = 2560, NIN1 = 4352, NIN1_SRC = 4168, KCAT = 1536;
constexpr size_t MiB = 1u << 20;
constexpr size_t WS_CTL = 0, CTL_ZERO_BYTES = 64 * 1024;
constexpr size_t WS_WKV = 1 * MiB, WS_WIN0 = 5 * MiB, WS_WOUT0 = 10 * MiB, WS_WOUT1 = 13 * MiB, WS_WUP0 = 16 * MiB, WS_WUP1 = 27 * MiB;
constexpr size_t WS_WDN0 = 38 * MiB, WS_WDN1 = WS_WDN0 + 11 * MiB / 2, WS_WIN1 = 49 * MiB;
constexpr size_t WS_XB16 = 58 * MiB, WS_MEM16 = 90 * MiB, WS_MK = 94 * MiB, WS_MVT = 98 * MiB, WS_SSP = 102 * MiB, WS_SSM = WS_SSP + 512 * 1024;
constexpr size_t WS_COSA = 103 * MiB, WS_SINA = 104 * MiB, WS_COSI = 105 * MiB, WS_SINI = WS_COSI + 512 * 1024, WS_MASK = 106 * MiB, WS_BIG = 110 * MiB;
constexpr size_t WS_XBR = WS_BIG, WS_GBR = WS_BIG + 32 * MiB, WS_CAT0 = WS_BIG + 64 * MiB;
constexpr size_t WS_CAT1 = WS_BIG, WS_KB = WS_BIG + 48 * MiB, WS_VT = WS_BIG + 80 * MiB, WS_IQ = WS_BIG + 112 * MiB, WS_IK = WS_BIG + 128 * MiB, WS_IW = WS_BIG + 130 * MiB;
constexpr size_t WS_ACT = WS_BIG, WS_HALO = WS_BIG + 88 * MiB;
constexpr size_t WS_END = WS_BIG + 131 * MiB;
static_assert(WS_WIN1 + (size_t)NIN1 * DM * 2 <= WS_XB16 && WS_HALO + (size_t)256 * 4 * 2 * DFF * 4 <= WS_END && WS_END <= 256 * MiB, "d_ws map");
constexpr int CW_BAR = 1024;

constexpr int RING_OFF = 0, RING_BYTES = 131072;
constexpr int LDSCTL_OFF = RING_BYTES, MISC_OFF = LDSCTL_OFF + 320;
constexpr int LDS_BYTES = 147456;
#define GAS __attribute__((address_space(1)))
#define LAS __attribute__((address_space(3)))
typedef unsigned short bf16;
typedef unsigned v4u __attribute__((ext_vector_type(4)));
typedef float f32x4 __attribute__((ext_vector_type(4)));
typedef short bf16x8 __attribute__((ext_vector_type(8)));
typedef GAS unsigned gu32;
typedef GAS unsigned long long gu64;
#define RLX_AGENT __ATOMIC_RELAXED, __HIP_MEMORY_SCOPE_AGENT
#define LDS_WAIT() asm volatile("s_waitcnt lgkmcnt(0)" ::: "memory")
#define VM_WAIT() asm volatile("s_waitcnt vmcnt(0)" ::: "memory")
__device__ __forceinline__ unsigned long long rt() { return __builtin_amdgcn_s_memrealtime(); }
__device__ __forceinline__ unsigned f2bf(float f) { unsigned u = __builtin_bit_cast(unsigned, f); return (u + 0x7fffu + ((u >> 16) & 1u)) >> 16; }
__device__ __forceinline__ unsigned pk2(float lo, float hi) { return f2bf(lo) | (f2bf(hi) << 16); }
#define XB_TMO      128
#define XB_XCNT(j)  (256  + 64 * (j))
#define XB_XSUB(j)  (1280 + 64 * (j))
#define XB_XGEN(j)  (2304 + 64 * (j))
#define XB_TOP      3328
#define XB_TOPGEN   3392
#define XCD_BAR_WORDS 3456
#define XB_SPIN_CAP (1u << 18)

__device__ __forceinline__ unsigned xb_ld(unsigned* p)              { return __hip_atomic_load(p, __ATOMIC_RELAXED, __HIP_MEMORY_SCOPE_AGENT); }
__device__ __forceinline__ unsigned xb_add(unsigned* p, unsigned v) { return __hip_atomic_fetch_add(p, v, __ATOMIC_RELAXED, __HIP_MEMORY_SCOPE_AGENT); }
__device__ __forceinline__ unsigned xb_xcc_id() { return (unsigned)__builtin_amdgcn_s_getreg((3 << 11) | 20) & 0xFu; }
#define XB_SPIN(cond, bar) do { unsigned _sp = 0; while (cond) { __builtin_amdgcn_s_sleep(1); \
    if ((++_sp & 255u) == 0u) { if (xb_ld(&(bar)[XB_TMO])) break; if (_sp > XB_SPIN_CAP) { atomicAdd(&(bar)[XB_TMO], 1u); break; } } } } while (0)

struct XcdBarrier {
    unsigned* bar; unsigned x;
    volatile LAS unsigned* st;
};

__device__ __forceinline__ XcdBarrier xcd_barrier_post(unsigned* bar, volatile LAS unsigned* st) {
    XcdBarrier b; b.bar = bar; b.x = xb_xcc_id(); b.st = st;
    if (threadIdx.x == 0) (void)xb_add(&bar[XB_XCNT(b.x)], 1u);
    return b;
}
__device__ __forceinline__ void xcd_barrier_complete(unsigned* bar, unsigned x, unsigned& nloc, unsigned& nx) {
    const unsigned G = gridDim.x * gridDim.y * gridDim.z;
    unsigned sum, cnt, mine, sp = 0u;
    for (;;) {
        sum = 0u; cnt = 0u; mine = 0u;
#pragma unroll
        for (unsigned j = 0; j < 16; ++j) { const unsigned c = xb_ld(&bar[XB_XCNT(j)]); sum += c; cnt += (c > 0u) ? 1u : 0u; mine = (j == x) ? c : mine; }
        if (sum == G) break;
        __builtin_amdgcn_s_sleep(1);
        if ((++sp & 255u) == 0u) { if (xb_ld(&bar[XB_TMO])) break; if (sp > XB_SPIN_CAP) { atomicAdd(&bar[XB_TMO], 1u); break; } }
    }
    nloc = mine > 0u ? mine : 1u; nx = cnt > 0u ? cnt : 1u;
}

__device__ __forceinline__ void xcd_barrier(const XcdBarrier& b) {
    asm volatile("s_waitcnt vmcnt(0)" ::: "memory");
    __syncthreads();
    if (threadIdx.x == 0) {
        unsigned* bar = b.bar;
        __builtin_amdgcn_s_waitcnt(0);
        unsigned nloc = b.st[0], nx = b.st[1];
        if (nloc == 0u) { xcd_barrier_complete(bar, b.x, nloc, nx); b.st[0] = nloc; b.st[1] = nx; }
        const unsigned old = xb_add(&bar[XB_XSUB(b.x)], 1u);
        const unsigned gen = old / nloc;
        if (old + 1u == (gen + 1u) * nloc) {
            __builtin_amdgcn_fence(__ATOMIC_RELEASE, "agent");
            asm volatile("s_waitcnt vmcnt(0)" ::: "memory");
            const unsigned og = xb_add(&bar[XB_TOP], 1u);
            const unsigned tg = og / nx;
            if (og + 1u == (tg + 1u) * nx) xb_add(&bar[XB_TOPGEN], 1u);
            else XB_SPIN(xb_ld(&bar[XB_TOPGEN]) == tg, bar);
            __builtin_amdgcn_fence(__ATOMIC_ACQUIRE, "agent");
            xb_add(&bar[XB_XGEN(b.x)], 1u);
            asm volatile("s_waitcnt vmcnt(0)" ::: "memory");
        } else {
            XB_SPIN(xb_ld(&bar[XB_XGEN(b.x)]) == gen, bar);
            __builtin_amdgcn_fence(__ATOMIC_ACQUIRE, "agent");
            asm volatile("s_waitcnt vmcnt(0)" ::: "memory");
        }
    }
    __syncthreads();
}
typedef float f32x16 __attribute__((ext_vector_type(16)));
typedef unsigned u32x2 __attribute__((ext_vector_type(2)));
using pg8::cvt_pk_bf16;
__device__ __forceinline__ float wave_sum(float v) {
#pragma unroll
    for (int o = 1; o < 64; o <<= 1) v += __shfl_xor(v, o);
    return v;
}
__device__ __forceinline__ bf16x8 pack8(const float* p) { v4u w; w.x = cvt_pk_bf16(p[0], p[1]); w.y = cvt_pk_bf16(p[2], p[3]); w.z = cvt_pk_bf16(p[4], p[5]); w.w = cvt_pk_bf16(p[6], p[7]); return __builtin_bit_cast(bf16x8, w); }
__device__ __forceinline__ float bf2f(bf16 v) { return __builtin_bit_cast(float, (unsigned)v << 16); }
__device__ __forceinline__ float sigmoidf_(float x) { return __builtin_amdgcn_rcpf(1.0f + __expf(-x)); }

__device__ __forceinline__ void p0_transpose_item(const float* W, int Nsrc, const float* g, bf16* WT, int K, int k0, int n0, int s0, int nvalid, LAS float* scr, int lane) {
#pragma unroll 8
    for (int i = 0; i < 32; ++i) { const int kk = 2 * i + (lane >> 5), cc = lane & 31;
        float v = 0.f; if (cc < nvalid) v = W[(size_t)(k0 + kk) * Nsrc + s0 + cc]; if (g) v *= g[k0 + kk];
        scr[kk * 33 + cc] = v; }
    LDS_WAIT(); asm volatile("" ::: "memory");
    const int c = lane & 7;
#pragma unroll
    for (int j = 0; j < 4; ++j) { const int n = (lane >> 3) + 8 * j; const LAS float* s = scr + (8 * c) * 33 + n;
        v4u o; o.x = cvt_pk_bf16(s[0 * 33], s[1 * 33]); o.y = cvt_pk_bf16(s[2 * 33], s[3 * 33]); o.z = cvt_pk_bf16(s[4 * 33], s[5 * 33]); o.w = cvt_pk_bf16(s[6 * 33], s[7 * 33]);
        *(v4u*)(WT + (size_t)(n0 + n) * K + k0 + 8 * c) = o; }
    LDS_WAIT(); asm volatile("" ::: "memory");
}
struct Ptrs {
    const float *x, *mem; const int* pos; const float *norm_mix, *norm_ffn, *mem_norm, *final_norm, *w_mem_kv, *w_ffn_up, *ffn_conv_w, *ffn_conv_b, *w_ffn_down;
    const float *lru_w_in, *lru_conv_w, *lru_conv_b, *lru_w_a, *lru_b_a, *lru_w_x, *lru_b_x, *lru_lambda, *lru_w_out, *dsa_w_in, *dsa_w_out;
    float* out; unsigned char* ws;
};
__device__ __forceinline__ void p0_prologue(const Ptrs& P, LAS unsigned char* lds, int gw, int NGW, int wave, int lane) {
    LAS float* scr = (LAS float*)(lds + wave * 16384);
    unsigned char* ws = P.ws;
    constexpr int I_KV = 16 * 64, I_IN0 = 16 * 80, I_OUT = 24 * 32, I_UP = 16 * 176, I_DN = 44 * 32, I_IN1 = 16 * 136;
    constexpr int NITEMS = I_KV + I_IN0 + 2 * I_OUT + 2 * I_UP + 2 * I_DN + I_IN1;
    for (int it = gw; it < NITEMS; it += NGW) {
        int r = it;
        if (r < I_KV) { const int kb = r / 64, nb = r % 64, l = nb / 32;
            p0_transpose_item(P.w_mem_kv + (size_t)l * 1024 * 1024, 1024, P.mem_norm, (bf16*)(ws + WS_WKV), 1024, kb * 64, nb * 32, (nb % 32) * 32, 32, scr, lane); continue; } r -= I_KV;
        if (r < I_IN0) { const int kb = r / 80, nb = r % 80;
            p0_transpose_item(P.lru_w_in, NIN0, P.norm_mix, (bf16*)(ws + WS_WIN0), 1024, kb * 64, nb * 32, nb * 32, 32, scr, lane); continue; } r -= I_IN0;
        if (r < 2 * I_OUT) { const int l = r / I_OUT, q = r % I_OUT, kb = q / 32, nb = q % 32;
            p0_transpose_item(l ? P.dsa_w_out : P.lru_w_out, 1024, nullptr, (bf16*)(ws + (l ? WS_WOUT1 : WS_WOUT0)), KCAT, kb * 64, nb * 32, nb * 32, 32, scr, lane); continue; } r -= 2 * I_OUT;
        if (r < 2 * I_UP) { const int l = r / I_UP, q = r % I_UP, kb = q / 176, nb = q % 176;
            const int tile = nb / 8, half = (nb % 8) / 4, j0 = (nb % 4) * 32;
            p0_transpose_item(P.w_ffn_up + (size_t)l * 1024 * NUP, NUP, P.norm_ffn + l * 1024, (bf16*)(ws + (l ? WS_WUP1 : WS_WUP0)), 1024, kb * 64, nb * 32, half * DFF + tile * 128 + j0, 32, scr, lane); continue; } r -= 2 * I_UP;
        if (r < 2 * I_DN) { const int l = r / I_DN, q = r % I_DN, kb = q / 32, nb = q % 32;
            p0_transpose_item(P.w_ffn_down + (size_t)l * DFF * 1024, 1024, nullptr, (bf16*)(ws + (l ? WS_WDN1 : WS_WDN0)), DFF, kb * 64, nb * 32, nb * 32, 32, scr, lane); continue; } r -= 2 * I_DN;
        { const int kb = r / 136, nb = r % 136, n0 = nb * 32; int s0, nv = 32;
            if (n0 < 3072) s0 = n0; else if (n0 < 3584) s0 = 3656 + (n0 - 3072); else if (n0 < 4096) s0 = 3072 + (n0 - 3584); else if (n0 < 4160) s0 = 3584 + (n0 - 4096);
            else if (n0 == 4160) { s0 = 3648; nv = 8; } else { s0 = 0; nv = 0; }
            p0_transpose_item(P.dsa_w_in, NIN1_SRC, P.norm_mix + 1024, (bf16*)(ws + WS_WIN1), 1024, kb * 64, n0, s0, nv, scr, lane); }
    }
    float* ssp = (float*)(ws + WS_SSP); float* ssm = (float*)(ws + WS_SSM);
    for (int m = gw; m < M + MMEM; m += NGW) {
        const bool is_x = m < M; const int r = is_x ? m : m - M;
        const f32x4* xr = (const f32x4*)((is_x ? P.x : P.mem) + (size_t)r * DM) + lane;
        unsigned long long* o8 = (unsigned long long*)((bf16*)(ws + (is_x ? WS_XB16 : WS_MEM16)) + (size_t)r * DM) + lane;
        float s = 0.f;
#pragma unroll
        for (int j = 0; j < 4; ++j) { const f32x4 v = xr[64 * j]; s += (v.x * v.x + v.y * v.y) + (v.z * v.z + v.w * v.w);
            o8[64 * j] = (unsigned long long)cvt_pk_bf16(v.x, v.y) | ((unsigned long long)cvt_pk_bf16(v.z, v.w) << 32); }
        s = wave_sum(s);
        if (lane == 0) { if (is_x) { *(f32x4*)(ssp + (size_t)r * 4) = (f32x4){s, 0.f, 0.f, 0.f}; } else ssm[r] = s; }
    }
    float *cosA = (float*)(ws + WS_COSA), *sinA = (float*)(ws + WS_SINA), *cosI = (float*)(ws + WS_COSI), *sinI = (float*)(ws + WS_SINI);
    for (int e = gw * 64 + lane; e < M * 24; e += NGW * 64) {
        const int row = e / 24, i = e % 24; const double p = (double)P.pos[row];
        if (i < 16) { const double a = p * pow(500000.0, -(double)(2 * i) / 32.0); cosA[row * 16 + i] = (float)cos(a); sinA[row * 16 + i] = (float)sin(a); }
        else { const int ii = i - 16; const double a = p * pow(500000.0, -(double)(2 * ii) / 16.0); cosI[row * 8 + ii] = (float)cos(a); sinI[row * 8 + ii] = (float)sin(a); }
    }
}
template <bool MASKED>
__device__ __forceinline__ void attn_unit(const bf16* Q, int qpitch, const bf16* K, int kpitch, const bf16* VT, int vtpitch, int ntiles,
                                          const unsigned* mask, bf16* O, int opitch, int lane) {
    const int qrow = lane & 31, hi = lane >> 5;
    bf16x8 qf[8];
#pragma unroll
    for (int s = 0; s < 8; ++s) qf[s] = *(const bf16x8*)(Q + (size_t)qrow * qpitch + 16 * s + 8 * hi);
    f32x16 oacc[4];
#pragma unroll
    for (int dt = 0; dt < 4; ++dt)
#pragma unroll
        for (int r = 0; r < 16; ++r) oacc[dt][r] = 0.f;
    float mrun = -1e30f, lrun = 0.f;
    const float cs = 1.4426950408889634f * 0.08838834764831845f;
    const int i5 = lane & 31, keyl = (i5 & ~12) | ((i5 & 4) << 1) | ((i5 & 8) >> 1);
    for (int kt = 0; kt < ntiles; ++kt) {
        const bf16* kp = K + (size_t)(kt * 32 + keyl) * kpitch + 8 * hi;
        bf16x8 kf[8];
#pragma unroll
        for (int s = 0; s < 8; ++s) kf[s] = *(const bf16x8*)(kp + 16 * s);
        bf16x8 vf[4][2];
#pragma unroll
        for (int dt = 0; dt < 4; ++dt)
#pragma unroll
            for (int s2 = 0; s2 < 2; ++s2) vf[dt][s2] = *(const bf16x8*)(VT + (size_t)(32 * dt + qrow) * vtpitch + kt * 32 + 16 * s2 + 8 * hi);
        unsigned mw = 0xffffffffu;
        if (MASKED) mw = mask[(size_t)qrow * 64 + kt] >> (8 * hi);
        f32x16 sacc;
#pragma unroll
        for (int r = 0; r < 16; ++r) sacc[r] = 0.f;
#pragma unroll
        for (int s = 0; s < 8; ++s) sacc = __builtin_amdgcn_mfma_f32_32x32x16_bf16(kf[s], qf[s], sacc, 0, 0, 0);
        float mx = -1e30f;
#pragma unroll
        for (int r = 0; r < 16; ++r) { const int sh = (r & 3) + 4 * ((r >> 2) & 1) + 16 * (r >> 3); const bool sel = !MASKED || ((mw >> sh) & 1u);
            sacc[r] = sel ? sacc[r] * cs : -1e30f; mx = fmaxf(mx, sacc[r]); }
        mx = fmaxf(mx, __shfl_xor(mx, 32));
        const float mnew = fmaxf(mrun, mx);
        const float alpha = exp2f(mrun - mnew);
        mrun = mnew;
        float p[16]; float ps = 0.f;
#pragma unroll
        for (int r = 0; r < 16; ++r) { p[r] = (sacc[r] > -1e29f) ? exp2f(sacc[r] - mnew) : 0.f; ps += p[r]; }
        lrun = lrun * alpha + ps;
        if (!__all(alpha == 1.0f)) {
#pragma unroll
            for (int dt = 0; dt < 4; ++dt)
#pragma unroll
                for (int r = 0; r < 16; ++r) oacc[dt][r] *= alpha;
        }
        bf16x8 pb[2];
        pb[0] = pack8(p); pb[1] = pack8(p + 8);
#pragma unroll
        for (int dt = 0; dt < 4; ++dt)
#pragma unroll
            for (int s2 = 0; s2 < 2; ++s2) oacc[dt] = __builtin_amdgcn_mfma_f32_32x32x16_bf16(vf[dt][s2], pb[s2], oacc[dt], 0, 0, 0);
    }
    const float ltot = lrun + __shfl_xor(lrun, 32);
    const float inv = 1.0f / ltot;
#pragma unroll
    for (int dt = 0; dt < 4; ++dt)
#pragma unroll
        for (int g4 = 0; g4 < 4; ++g4) { u32x2 w; w.x = cvt_pk_bf16(oacc[dt][4 * g4] * inv, oacc[dt][4 * g4 + 1] * inv); w.y = cvt_pk_bf16(oacc[dt][4 * g4 + 2] * inv, oacc[dt][4 * g4 + 3] * inv);
            *(u32x2*)(O + (size_t)qrow * opitch + 32 * dt + 8 * g4 + 4 * hi) = w; }
}
__device__ __forceinline__ void memattn_unit(unsigned char* ws, int l, bf16* CAT, int u, int lane) {
    const int qt = u & 63, h = (u >> 6) & 3, b = u >> 8;
    bf16* q = CAT + (size_t)(b * SEQ + qt * 32) * KCAT + 1024 + h * 128;
    const bf16* k = (const bf16*)(ws + WS_MK) + ((size_t)l * MMEM + b * MEMT) * 512 + h * 128;
    const bf16* vt = (const bf16*)(ws + WS_MVT) + (((size_t)l * 8 + b) * 4 + h) * 128 * 256;
    attn_unit<false>(q, KCAT, k, 512, vt, 256, 8, nullptr, q, KCAT, lane);
}
__device__ __forceinline__ void dsa_unit(unsigned char* ws, int u, int lane) {
    const int qt = u & 63, h = (u >> 6) & 7, b = u >> 9;
    bf16* q = (bf16*)(ws + WS_CAT1) + (size_t)(b * SEQ + qt * 32) * KCAT + h * 128;
    const bf16* k = (const bf16*)(ws + WS_KB) + (size_t)(b * SEQ) * 1024 + h * 128;
    const bf16* vt = (const bf16*)(ws + WS_VT) + ((size_t)b * 8 + h) * 128 * 2048;
    const unsigned* mk = (const unsigned*)(ws + WS_MASK) + (size_t)(b * SEQ + qt * 32) * 64;
    attn_unit<true>(q, KCAT, k, 1024, vt, 2048, qt + 1, mk, q, KCAT, lane);
}

__device__ __forceinline__ unsigned mono_key(float s) { unsigned b = __builtin_bit_cast(unsigned, s); if ((b << 1) == 0u) b = 0u; return (b & 0x80000000u) ? ~b : (b | 0x80000000u); }
__device__ __forceinline__ int half_sum(int v) {
#pragma unroll
    for (int o = 1; o < 32; o <<= 1) v += __shfl_xor(v, o);
    return v;
}
template <int JJ>
__device__ __forceinline__ void topk_pass(unsigned char* ws, LAS unsigned* SC, const bf16x8 (&af)[4], int b, int t0, int ntile, int lane) {
    const int c = lane & 31, hi = lane >> 5;
    const bf16* IK = (const bf16*)(ws + WS_IK); const float* IW = (const float*)(ws + WS_IW);
    unsigned* MASK = (unsigned*)(ws + WS_MASK);
    const int tq = t0 + 2 * hi + JJ;
    float w[8];
    { const float* wp = IW + (size_t)(b * SEQ + tq) * 8;
#pragma unroll
      for (int h = 0; h < 8; ++h) w[h] = wp[h] * 0.125f; }
    LAS unsigned* sc = SC + hi * 2048 + c;
#pragma unroll 1
    for (int kt = 0; kt < 64; ++kt) {
        unsigned key_u = 0u;
        if (kt < ntile) {
            const int key = kt * 32 + c;
            const bf16* bp = IK + (size_t)(b * SEQ + key) * 64 + 8 * hi;
            f32x16 acc;
#pragma unroll
            for (int r = 0; r < 16; ++r) acc[r] = 0.f;
#pragma unroll
            for (int s = 0; s < 4; ++s) acc = __builtin_amdgcn_mfma_f32_32x32x16_bf16(af[s], *(const bf16x8*)(bp + 16 * s), acc, 0, 0, 0);
            float s_ = 0.f;
#pragma unroll
            for (int h = 0; h < 8; ++h) s_ += w[h] * fmaxf(acc[8 * JJ + h], 0.f);
            key_u = (key <= tq) ? mono_key(s_) : 0u;
        }
        sc[kt * 32] = key_u;
    }
    LDS_WAIT(); asm volatile("" ::: "memory");
    unsigned U[64];
#pragma unroll
    for (int kt = 0; kt < 64; ++kt) U[kt] = sc[kt * 32];
    const bool all_valid = (tq + 1 <= 256);
    bool done = all_valid; unsigned T = all_valid ? 1u : 0u;
#pragma unroll 1
    for (int bit = 31; bit >= 0; --bit) {
        if (__all(done)) break;
        const unsigned cand = T | (1u << bit); int cnt = 0;
#pragma unroll
        for (int kt = 0; kt < 64; ++kt) cnt += (U[kt] >= cand) ? 1 : 0;
        cnt = half_sum(cnt);
        if (!done) { if (cnt >= 256) T = cand; if (cnt == 256) done = true; }
    }
    int ngt = 0;
#pragma unroll
    for (int kt = 0; kt < 64; ++kt) ngt += (U[kt] > T) ? 1 : 0;
    ngt = half_sum(ngt);
    const int need = all_valid ? 0x7fffffff : 256 - ngt;
    int eqc = 0; const unsigned lt = (1u << c) - 1u;
#pragma unroll 1
    for (int kt = 0; kt < ntile; ++kt) {
        const unsigned uk = sc[kt * 32];
        const bool eq = uk == T, gt = uk > T;
        const unsigned long long bal = __ballot(eq); const unsigned hb = hi ? (unsigned)(bal >> 32) : (unsigned)bal;
        const int rank = __popc(hb & lt);
        const bool sel = gt || (eq && (eqc + rank < need));
        eqc += __popc(hb);
        const unsigned long long wb = __ballot(sel);
        if (lane == 0) MASK[(size_t)(b * SEQ + t0 + JJ) * 64 + kt] = (unsigned)wb;
        if (lane == 32) MASK[(size_t)(b * SEQ + t0 + 2 + JJ) * 64 + kt] = (unsigned)(wb >> 32);
    }
    LDS_WAIT(); asm volatile("" ::: "memory");
}
__device__ __forceinline__ void topk_unit(unsigned char* ws, LAS unsigned char* lds, int wave, int u, int lane) {
    const int b = u >> 9, t0 = (u & 511) * 4;
    const int c = lane & 31, hi = lane >> 5;
    const bf16* IQ = (const bf16*)(ws + WS_IQ);
    LAS unsigned* SC = (LAS unsigned*)(lds + wave * 16384);
    bf16x8 af[4];
    { const int i = c, qi = t0 + 2 * ((i >> 2) & 1) + ((i >> 4) & 1), hd = (i & 3) | (((i >> 3) & 1) << 2);
      const bf16* ap = IQ + (size_t)(b * SEQ + qi) * 512 + hd * 64 + 8 * hi;
#pragma unroll
      for (int s = 0; s < 4; ++s) af[s] = *(const bf16x8*)(ap + 16 * s); }
    const int ntile = (t0 + 3) / 32 + 1;
    topk_pass<0>(ws, SC, af, b, t0, ntile, lane);
    topk_pass<1>(ws, SC, af, b, t0, ntile, lane);
}
__device__ __forceinline__ void lru_item(const Ptrs& P, LAS unsigned char* lds, int b, int n, int tid, int wave, int lane) {
    unsigned char* ws = P.ws;
    const bf16* XBR = (const bf16*)(ws + WS_XBR); const bf16* GBR = (const bf16*)(ws + WS_GBR); bf16* CAT = (bf16*)(ws + WS_CAT0);
    LAS bf16* WAt = (LAS bf16*)lds;
    LAS bf16* WXt = (LAS bf16*)(lds + 9216);
    LAS float* SUM = (LAS float*)(lds + 18432);
    LAS float* XC = (LAS float*)(lds + 26624 + wave * 8320);
    for (int e = tid; e < 4096; e += 512) { const int in = e >> 6, out = e & 63;
        WAt[out * 72 + in] = (bf16)pg8::bf1(P.lru_w_a[((size_t)n * 64 + in) * 64 + out]);
        WXt[out * 72 + in] = (bf16)pg8::bf1(P.lru_w_x[((size_t)n * 64 + in) * 64 + out]); }
    __syncthreads();
    const int c = lane & 31, hi = lane >> 5;
    float ba[2], bx[2], sp[2];
#pragma unroll
    for (int nt = 0; nt < 2; ++nt) { const int ch = n * 64 + c + 32 * nt; ba[nt] = P.lru_b_a[ch]; bx[nt] = P.lru_b_x[ch]; sp[nt] = log1pf(__expf(-P.lru_lambda[ch])); }
    const int chl = n * 64 + lane;
    const float cw0 = P.lru_conv_w[chl], cw1 = P.lru_conv_w[1024 + chl], cw2 = P.lru_conv_w[2048 + chl], cw3 = P.lru_conv_w[3072 + chl], cb = P.lru_conv_b[chl];
    float R[2] = {0.f, 0.f};
    for (int round = 0; round < 8; ++round) {
        const int tb = round * 256 + wave * 32;
        const size_t rowb = (size_t)b * SEQ + tb;
        { const bf16* xp = XBR + rowb * 1024 + chl;
          float xm3 = 0.f, xm2 = 0.f, xm1 = 0.f;
          if (tb > 0) { xm3 = bf2f(xp[-3 * 1024]); xm2 = bf2f(xp[-2 * 1024]); xm1 = bf2f(xp[-1024]); }
#pragma unroll 8
          for (int tt = 0; tt < 32; ++tt) { const float x0 = bf2f(xp[(size_t)tt * 1024]);
              XC[tt * 65 + lane] = cb + cw0 * xm3 + cw1 * xm2 + cw2 * xm1 + cw3 * x0; xm3 = xm2; xm2 = xm1; xm1 = x0; } }
        LDS_WAIT(); asm volatile("" ::: "memory");
        f32x16 accA[2], accX[2];
#pragma unroll
        for (int nt = 0; nt < 2; ++nt)
#pragma unroll
            for (int r = 0; r < 16; ++r) { accA[nt][r] = 0.f; accX[nt][r] = 0.f; }
#pragma unroll
        for (int s = 0; s < 4; ++s) { float t8[8];
#pragma unroll
            for (int j = 0; j < 8; ++j) t8[j] = XC[c * 65 + 16 * s + 8 * hi + j];
            const bf16x8 af = pack8(t8);
#pragma unroll
            for (int nt = 0; nt < 2; ++nt) { const bf16x8 wa = *(const LAS bf16x8*)(WAt + (c + 32 * nt) * 72 + 16 * s + 8 * hi), wx = *(const LAS bf16x8*)(WXt + (c + 32 * nt) * 72 + 16 * s + 8 * hi);
                accA[nt] = __builtin_amdgcn_mfma_f32_32x32x16_bf16(af, wa, accA[nt], 0, 0, 0); accX[nt] = __builtin_amdgcn_mfma_f32_32x32x16_bf16(af, wx, accX[nt], 0, 0, 0); } }
        float hloc[2][16], pl[2][16], gg[2][16];
        const int par = round & 1;
#pragma unroll
        for (int nt = 0; nt < 2; ++nt) {
            const int ch = n * 64 + c + 32 * nt;
            float Ag[4], Hg[4];
#pragma unroll
            for (int g = 0; g < 4; ++g) { float h = 0.f, p = 1.f;
#pragma unroll
                for (int j = 0; j < 4; ++j) { const int r = 4 * g + j, tok = j + 8 * g + 4 * hi;
                    const float xc = XC[tok * 65 + c + 32 * nt];
                    const float gb = bf2f(GBR[(rowb + tok) * 1024 + ch]);
                    const float rg = sigmoidf_(accA[nt][r] + ba[nt]), ig = sigmoidf_(accX[nt][r] + bx[nt]);
                    const float la = -8.0f * rg * sp[nt], a = __expf(la), z = 2.0f * la;
                    const float em = (z > -0.05f) ? -z * (1.0f + z * (0.5f + z * (0.16666667f + z * 0.041666667f))) : 1.0f - __expf(z);
                    const float bt = sqrtf(em) * (ig * xc);
                    h = a * h + bt; p = p * a; hloc[nt][r] = h; pl[nt][r] = p;
                    const float u2 = 1.5957691216057308f * (gb + 0.044715f * gb * gb * gb);
                    gg[nt][r] = gb * sigmoidf_(u2); }
                Ag[g] = p; Hg[g] = h; }
            float cc = 0.f, qq = 1.f;
#pragma unroll
            for (int g = 0; g < 4; ++g) { const float Ap = __shfl_xor(Ag[g], 32), Hp = __shfl_xor(Hg[g], 32);
                const float fA = hi ? Ap : Ag[g], fH = hi ? Hp : Hg[g], sA = hi ? Ag[g] : Ap, sH = hi ? Hg[g] : Hp;
                const float c1 = fA * cc + fH, q1 = qq * fA;
                const float hin = hi ? c1 : cc, pin = hi ? q1 : qq;
                cc = sA * c1 + sH; qq = q1 * sA;
#pragma unroll
                for (int j = 0; j < 4; ++j) { const int r = 4 * g + j; hloc[nt][r] = hloc[nt][r] + pl[nt][r] * hin; pl[nt][r] = pl[nt][r] * pin; } }
            if (hi == 0) { LAS float* sp2 = SUM + ((par * 8 + wave) * 64 + c + 32 * nt) * 2; sp2[0] = cc; sp2[1] = qq; }
        }
        LDS_WAIT(); __syncthreads();
#pragma unroll
        for (int nt = 0; nt < 2; ++nt) {
            const int ch = n * 64 + c + 32 * nt;
            float Rw = R[nt], hin = 0.f;
#pragma unroll
            for (int w2 = 0; w2 < 8; ++w2) { const LAS float* sp2 = SUM + ((par * 8 + w2) * 64 + c + 32 * nt) * 2; const float C = sp2[0], Q = sp2[1];
                if (w2 == wave) hin = Rw; Rw = Q * Rw + C; }
            R[nt] = Rw;
#pragma unroll
            for (int r = 0; r < 16; ++r) { const int tok = (r & 3) + 8 * (r >> 2) + 4 * hi;
                const float y = (hloc[nt][r] + pl[nt][r] * hin) * gg[nt][r];
                CAT[(rowb + tok) * KCAT + ch] = (bf16)pg8::bf1(y); }
        }
    }
    __syncthreads();
}

__device__ __forceinline__ void ffn_fixup_item(const Ptrs& P, int l, int chunk, int tid) {
    unsigned char* ws = P.ws;
    const float* HALO = (const float*)(ws + WS_HALO); bf16* ACT = (bf16*)(ws + WS_ACT);
    const float* cw = P.ffn_conv_w + (size_t)l * 3 * NUP; const float* cb = P.ffn_conv_b + (size_t)l * NUP;
    const bool first = (chunk % 32) == 0;
    const size_t r0 = (size_t)chunk * 64;
    for (int ch = tid; ch < DFF; ch += 512) {
        float y[2][2];
#pragma unroll
        for (int hf = 0; hf < 2; ++hf) {
            const float* hc = HALO + ((size_t)(chunk * 4) * 2 + hf) * DFF + ch;
            const float u0 = hc[0], u1 = hc[2 * DFF];
            float um2 = 0.f, um1 = 0.f;
            if (!first) { const float* hpv = HALO + ((size_t)((chunk - 1) * 4) * 2 + hf) * DFF + ch; um2 = hpv[2 * 2 * DFF]; um1 = hpv[3 * 2 * DFF]; }
            const int cc = hf * DFF + ch;
            const float w0 = cw[cc], w1 = cw[NUP + cc], w2 = cw[2 * NUP + cc], bb = cb[cc];
            y[hf][0] = bb + w0 * um2 + w1 * um1 + w2 * u0;
            y[hf][1] = bb + w0 * um1 + w1 * u0 + w2 * u1;
        }
#pragma unroll
        for (int k = 0; k < 2; ++k) { const float yg = y[0][k]; ACT[(r0 + k) * DFF + ch] = (bf16)pg8::bf1(yg * __builtin_amdgcn_rcpf(1.0f + __expf(-yg)) * y[1][k]); }
    }
}

__device__ __forceinline__ void final_norm_rows(const Ptrs& P, int gw, int NGW, int lane) {
    const float* ssp = (const float*)(P.ws + WS_SSP);
    for (int m = gw; m < M; m += NGW) {
        const float rs = pg8::rstd4(ssp, m);
        f32x4* xr = (f32x4*)(P.out + (size_t)m * DM) + lane; const f32x4* gr = (const f32x4*)P.final_norm + lane;
#pragma unroll
        for (int j = 0; j < 4; ++j) { const f32x4 v = xr[64 * j], g = gr[64 * j]; xr[64 * j] = v * rs * g; }
    }
}
struct Args { const void* in[23]; float* out; unsigned char* ws; int ph_lo, ph_hi; };
__global__ void __launch_bounds__(NWAVES * 64, 2) trunk_fwd(Args args) {
    extern __shared__ __attribute__((aligned(16))) unsigned char lds_raw[];
    LAS unsigned char* lds = (LAS unsigned char*)lds_raw;
    const int tid = threadIdx.x, lane = tid & 63, wave = __builtin_amdgcn_readfirstlane(tid >> 6);
    const int G = gridDim.x, bx = blockIdx.x;
    const int vcu = (G % 8 == 0) ? (bx % 8) * (G / 8) + bx / 8 : bx;
    const int gw = vcu * NWAVES + wave, NGW = G * NWAVES;
    Ptrs P;
    P.x = (const float*)args.in[0]; P.mem = (const float*)args.in[1]; P.pos = (const int*)args.in[2]; P.norm_mix = (const float*)args.in[3]; P.norm_ffn = (const float*)args.in[4];
    P.mem_norm = (const float*)args.in[5]; P.final_norm = (const float*)args.in[6]; P.w_mem_kv = (const float*)args.in[7]; P.w_ffn_up = (const float*)args.in[8];
    P.ffn_conv_w = (const float*)args.in[9]; P.ffn_conv_b = (const float*)args.in[10]; P.w_ffn_down = (const float*)args.in[11]; P.lru_w_in = (const float*)args.in[12];
    P.lru_conv_w = (const float*)args.in[13]; P.lru_conv_b = (const float*)args.in[14]; P.lru_w_a = (const float*)args.in[15]; P.lru_b_a = (const float*)args.in[16];
    P.lru_w_x = (const float*)args.in[17]; P.lru_b_x = (const float*)args.in[18]; P.lru_lambda = (const float*)args.in[19]; P.lru_w_out = (const float*)args.in[20];
    P.dsa_w_in = (const float*)args.in[21]; P.dsa_w_out = (const float*)args.in[22]; P.out = args.out; P.ws = args.ws;
    unsigned char* ws = args.ws;
    for (int u = tid; u < (LDS_BYTES - LDSCTL_OFF) / 4; u += NWAVES * 64) ((LAS unsigned*)(lds + LDSCTL_OFF))[u] = 0u;
    __syncthreads();
    const int lo = args.ph_lo, hi = args.ph_hi;
    XcdBarrier bar; bar.bar = (unsigned*)(ws + WS_CTL) + CW_BAR; bar.x = 0; bar.st = nullptr;
    if (hi - lo > 1) bar = xcd_barrier_post((unsigned*)(ws + WS_CTL) + CW_BAR, (volatile LAS unsigned*)(lds + MISC_OFF) + 8);
#ifndef PH_MASK
#define PH_MASK 0x7fff
#endif
#define IN(k) ((((PH_MASK) >> (k)) & 1) && lo <= (k) && (k) < hi)
#define SEAM(k) do { if (IN(k) && IN((k) + 1)) xcd_barrier(bar); } while (0)
    float* ssp = (float*)(ws + WS_SSP);
    bf16* xb16 = (bf16*)(ws + WS_XB16);

    if (IN(0)) { int ln = lane; asm volatile("" : "+v"(ln)); p0_prologue(P, lds, gw, NGW, wave, ln); }
    SEAM(0);
    if (IN(1)) {
        { pg8::Gemm g{(const bf16*)(ws + WS_MEM16), (const bf16*)(ws + WS_WKV), MMEM, 2048, DM}; pg8::StaticOrder S; S.init(MMEM, 2048, G, (bx + G / 2) % G);
          pg8::EpiKV E{(const float*)(ws + WS_SSM), (bf16*)(ws + WS_MK), (bf16*)(ws + WS_MVT)};
          pg8::gemm_phase<pg8::EpiKV, pg8::StaticOrder, true, true>(lds + RING_OFF, g, S, E); }
        { pg8::Gemm g{xb16, (const bf16*)(ws + WS_WIN0), M, NIN0, DM}; pg8::StaticOrder S; S.init(M, NIN0, G, bx);
          pg8::EpiIn0 E{ssp, (bf16*)(ws + WS_XBR), (bf16*)(ws + WS_GBR), (bf16*)(ws + WS_CAT0)};
          pg8::gemm_phase<pg8::EpiIn0, pg8::StaticOrder, true, true>(lds + RING_OFF, g, S, E); }
    }
    SEAM(1);
    if (IN(2)) {
        int ln = lane, td = tid; asm volatile("" : "+v"(ln), "+v"(td));
        if (bx < 128) lru_item(P, lds, bx >> 4, bx & 15, td, wave, ln);
        else { const int nw = (G - 128) * NWAVES, w0 = (bx - 128) * NWAVES + wave;
            for (int u = w0; u < 2048; u += nw) memattn_unit(ws, 0, (bf16*)(ws + WS_CAT0), u, ln); }
    }
    SEAM(2);
    if (IN(3)) { pg8::Gemm g{(const bf16*)(ws + WS_CAT0), (const bf16*)(ws + WS_WOUT0), M, DM, KCAT}; pg8::StaticOrder S; S.init(M, DM, G, bx);
        pg8::EpiOut E{P.x, P.out, xb16, ssp};
        pg8::gemm_phase<pg8::EpiOut, pg8::StaticOrder, false, true>(lds + RING_OFF, g, S, E); }
    SEAM(3);
    for (int l = 0; l < 2; ++l) {
        const int pb = l ? 11 : 4;
        if (l == 1) {
            if (IN(7)) { pg8::Gemm g{xb16, (const bf16*)(ws + WS_WIN1), M, NIN1, DM}; pg8::StaticOrder S; S.init(M, NIN1, G, bx);
                pg8::EpiIn1 E{ssp, (const float*)(ws + WS_COSA), (const float*)(ws + WS_SINA), (const float*)(ws + WS_COSI), (const float*)(ws + WS_SINI),
                              (bf16*)(ws + WS_CAT1), (bf16*)(ws + WS_KB), (bf16*)(ws + WS_VT), (bf16*)(ws + WS_IQ), (bf16*)(ws + WS_IK), (float*)(ws + WS_IW)};
                pg8::gemm_phase<pg8::EpiIn1, pg8::StaticOrder, true, true>(lds + RING_OFF, g, S, E); }
            SEAM(7);
            if (IN(8)) { int ln = lane; asm volatile("" : "+v"(ln)); for (int u = gw; u < 2048; u += NGW) { topk_unit(ws, lds, wave, u, ln); topk_unit(ws, lds, wave, 4095 - u, ln); } }
            SEAM(8);
            if (IN(9)) { int ln = lane; asm volatile("" : "+v"(ln)); for (int u = gw; u < 2048; u += NGW) { dsa_unit(ws, u, ln); dsa_unit(ws, 4095 - u, ln); memattn_unit(ws, 1, (bf16*)(ws + WS_CAT1), u, ln); } }
            SEAM(9);
            if (IN(10)) { pg8::Gemm g{(const bf16*)(ws + WS_CAT1), (const bf16*)(ws + WS_WOUT1), M, DM, KCAT}; pg8::StaticOrder S; S.init(M, DM, G, bx);
                pg8::EpiOut E{P.out, P.out, xb16, ssp};
                pg8::gemm_phase<pg8::EpiOut, pg8::StaticOrder, false, true>(lds + RING_OFF, g, S, E); }
            SEAM(10);
        }
        if (IN(pb)) { pg8::Gemm g{xb16, (const bf16*)(ws + (l ? WS_WUP1 : WS_WUP0)), M, NUP, DM}; pg8::StaticOrder S; S.init(M, NUP, G, bx);
            pg8::EpiUp E{ssp, P.ffn_conv_w + (size_t)l * 3 * NUP, P.ffn_conv_b + (size_t)l * NUP, (bf16*)(ws + WS_ACT), (float*)(ws + WS_HALO)};
            pg8::gemm_phase<pg8::EpiUp, pg8::StaticOrder, true, true>(lds + RING_OFF, g, S, E); }
        SEAM(pb);
        if (IN(pb + 1)) { int td = tid; asm volatile("" : "+v"(td)); for (int ck = bx; ck < 256; ck += G) ffn_fixup_item(P, l, ck, td); }
        SEAM(pb + 1);
        if (IN(pb + 2)) { pg8::Gemm g{(const bf16*)(ws + WS_ACT), (const bf16*)(ws + (l ? WS_WDN1 : WS_WDN0)), M, DM, DFF}; pg8::StaticOrder S; S.init(M, DM, G, bx);
            pg8::EpiOut E{P.out, P.out, xb16, ssp};
            pg8::gemm_phase<pg8::EpiOut, pg8::StaticOrder, false, true>(lds + RING_OFF, g, S, E); }
        SEAM(pb + 2);
    }
    if (IN(14)) { int ln = lane; asm volatile("" : "+v"(ln)); final_norm_rows(P, gw, NGW, ln); }
#undef IN
#undef SEAM
}

extern "C" void kernel_launch(void* const* d_in, const int* in_sizes, int n_in, void* d_out, int out_size, void* d_ws, size_t ws_size, hipStream_t stream) {
    static int grid = 0;
    if (grid == 0) {
        if (n_in != 23 || out_size != M * DM || ws_size < WS_END) { fprintf(stderr, "kernel_launch: unexpected problem shape (n_in %d out %d ws %zu)\n", n_in, out_size, ws_size); grid = -1; return; }
        int dev = 0, cus = 0;
        if (hipGetDevice(&dev) != hipSuccess || hipDeviceGetAttribute(&cus, hipDeviceAttributeMultiprocessorCount, dev) != hipSuccess) { grid = -1; return; }
        if (hipFuncSetAttribute((const void*)trunk_fwd, hipFuncAttributeMaxDynamicSharedMemorySize, LDS_BYTES) != hipSuccess) { fprintf(stderr, "kernel_launch: hipFuncSetAttribute failed\n"); grid = -1; return; }
        int per_cu = 0;
        if (hipOccupancyMaxActiveBlocksPerMultiprocessor(&per_cu, (const void*)trunk_fwd, NWAVES * 64, LDS_BYTES) != hipSuccess || per_cu < 1) fprintf(stderr, "kernel_launch: occupancy query says %d\n", per_cu);
        (void)hipGetLastError();
        grid = cus;
        if (grid != 256) { fprintf(stderr, "kernel_launch: built for 256 CUs, found %d\n", grid); grid = -1; return; }
    }
    if (grid < 0) return;
    if (hipMemsetAsync((char*)d_ws + WS_CTL, 0, CTL_ZERO_BYTES, stream) != hipSuccess) return;
    Args a{};
    for (int i = 0; i < 23; ++i) a.in[i] = d_in[i];
    a.out = (float*)d_out; a.ws = (unsigned char*)d_ws;
#if MK_N_LAUNCHES == 1
    a.ph_lo = 0; a.ph_hi = N_PHASES;
    hipLaunchKernelGGL(trunk_fwd, dim3(grid), dim3(NWAVES * 64), LDS_BYTES, stream, a);
#else
    for (int p = 0; p < N_PHASES; ++p) { a.ph_lo = p; a.ph_hi = p + 1; hipLaunchKernelGGL(trunk_fwd, dim3(grid), dim3(NWAVES * 64), LDS_BYTES, stream, a); }
#endif
}
```

```cpp
#include <hip/hip_runtime.h>
#include <cstdio>
#include <cstdint>
namespace pg8 {
#define PG8_LAS __attribute__((address_space(3)))
typedef unsigned short bf16_t;
typedef short bf16x8 __attribute__((ext_vector_type(8)));
typedef float f32x4 __attribute__((ext_vector_type(4)));
typedef unsigned u32x4 __attribute__((ext_vector_type(4)));
constexpr int BM = 256, BK = 64, HALF = 128, HTB = HALF * BK * 2  , STAGE_BYTES = 8 * HTB, NXCD = 8, WGM = 8;

__host__ __device__ __forceinline__ int lds_byte(int r, int c) { const int st = (r >> 4) * 2 + (c >> 5), rr = r & 15, cc = c & 31, ob = rr * 64 + cc * 2; return st * 1024 + (ob ^ (((ob >> 9) & 1) << 5)); }
__host__ __device__ __forceinline__ void stage_rc(int b, int& R, int& C) { const int st = b / 1024, sb = b % 1024, swz = sb ^ (((sb >> 9) & 1) << 5); R = (st >> 1) * 16 + swz / 64; C = (st & 1) * 32 + (swz % 64) / 2; }
__host__ __device__ __forceinline__ int perm32(int rho) { const int n = rho >> 4, i = rho & 15; return 8 * (i >> 2) + 4 * n + (i & 3); }

struct Unit { int pm, pn; };
struct Gemm { const bf16_t* A; const bf16_t* Bt; int M, N, K; };

struct StaticOrder {
    int nM, nN, nwg, G, c;
    __host__ __device__ void init(int M, int N, int G_, int c_) { nM = M / BM; nN = N / BM; nwg = nM * nN; G = G_; c = c_; }
    __host__ __device__ bool next(int i, Unit& u) const {
        const long L = (long)i * G + c; if (L >= nwg) return false;
        int wgid = (int)L; { const int q = nwg / NXCD, r = nwg % NXCD, xcd = wgid % NXCD, off = wgid / NXCD; wgid = (xcd < r ? xcd * (q + 1) : r * (q + 1) + (xcd - r) * q) + off; }
        const int nig = WGM * nN, gid = wgid / nig, fm = gid * WGM, gsz = (nM - fm) < WGM ? (nM - fm) : WGM;
        u.pm = fm + ((wgid % nig) % gsz); u.pn = (wgid % nig) / gsz; return true;
    }
    __device__ __forceinline__ void a_ready(const Unit&) const {}
    __device__ __forceinline__ void done(const Unit&) const {}
};

__device__ __forceinline__ unsigned cvt_pk_bf16(float lo, float hi) { unsigned r; asm volatile("v_cvt_pk_bf16_f32 %0, %1, %2" : "=v"(r) : "v"(lo), "v"(hi)); return r; }

template <class Epi, class Sched, bool ALIGN_EPI = false, bool SP2 = false>
__device__ __forceinline__ void gemm_phase(PG8_LAS unsigned char* lds, const Gemm g, const Sched& S, const Epi& E) {
    int tid_ = threadIdx.x; asm volatile("" : "+v"(tid_));
    const int tid = tid_, wid = __builtin_amdgcn_readfirstlane(tid >> 6), lane = tid & 63, wr = wid >> 2, wc = wid & 3, fr = lane & 15, fq = lane >> 4;
    const int K = g.K, nt = K / BK;
    unsigned voffA[2], voffB[2];
#pragma unroll
    for (int i = 0; i < 2; ++i) { int R, C; stage_rc(tid * 16 + i * 8192, R, C); const int Rb = Epi::PERM ? ((R & ~31) + perm32(R & 31)) : R;
        voffA[i] = (unsigned)(R * K + C) * 2u; voffB[i] = (unsigned)(Rb * K + C) * 2u; }
    const size_t kstep = (size_t)(BK * 2);
    const size_t hstep = (size_t)HALF * K * 2;
    const size_t tstep = 2 * hstep;
    const unsigned ldsw = (unsigned)wid * 1024u;
    const int aoff = lds_byte(wr * 64 + fr, fq * 8), boff = lds_byte(wc * 32 + fr, fq * 8);
#define PG8_SA(b, h) (((b) * 2 + (h)) * HTB)
#define PG8_SB(b, h) ((4 + (b) * 2 + (h)) * HTB)
#define PG8_STAGE(bufoff, gbase, voff) do { _Pragma("unroll") for (int _i = 0; _i < 2; ++_i) \
        __builtin_amdgcn_global_load_lds((const unsigned*)((const char*)(gbase) + (voff)[_i]), (PG8_LAS unsigned*)(lds + (bufoff) + ldsw + _i * 8192), 16, 0, 0); } while (0)
#define PG8_LDA(dst, b, h) do { _Pragma("unroll") for (int m = 0; m < 4; ++m) _Pragma("unroll") for (int k = 0; k < 2; ++k) dst[m][k] = *(const PG8_LAS bf16x8*)(lds + PG8_SA(b, h) + aoff + m * 2048 + k * 1024); } while (0)
#define PG8_LDB(dst, b, h) do { _Pragma("unroll") for (int n = 0; n < 2; ++n) _Pragma("unroll") for (int k = 0; k < 2; ++k) dst[n][k] = *(const PG8_LAS bf16x8*)(lds + PG8_SB(b, h) + boff + n * 2048 + k * 1024); } while (0)
#define PG8_MMA(ai, bj, At, Bt) do { __builtin_amdgcn_s_setprio(1); _Pragma("unroll") for (int m = 0; m < 4; ++m) _Pragma("unroll") for (int n = 0; n < 2; ++n) _Pragma("unroll") for (int k = 0; k < 2; ++k) \
        acc[ai][bj][m][n] = __builtin_amdgcn_mfma_f32_16x16x32_bf16(Bt[n][k], At[m][k], acc[ai][bj][m][n], 0, 0, 0); __builtin_amdgcn_s_setprio(0); } while (0)
#define PG8_WAIT_V(n) asm volatile("s_waitcnt vmcnt(" #n ")" ::: "memory")
#define PG8_WAIT_L(n) asm volatile("s_waitcnt lgkmcnt(" #n ")" ::: "memory")
#define PG8_BAR __builtin_amdgcn_s_barrier()
#define PG8_SCHED __builtin_amdgcn_sched_barrier(0)
    Unit cur, nxt; int ui = 0;
    if (!S.next(0, cur)) return;
    f32x4 acc[2][2][4][2];
#pragma unroll
    for (int a = 0; a < 2; ++a)
#pragma unroll
        for (int b = 0; b < 2; ++b)
#pragma unroll
            for (int m = 0; m < 4; ++m)
#pragma unroll
                for (int n = 0; n < 2; ++n) acc[a][b][m][n] = (f32x4){0.f, 0.f, 0.f, 0.f};
    bf16x8 At[4][2], B0[2][2], B1[2][2];
    const char* cA = (const char*)g.A + (size_t)cur.pm * tstep; const char* cB = (const char*)g.Bt + (size_t)cur.pn * tstep;
    S.a_ready(cur);
    if constexpr (SP2) {
        PG8_STAGE(PG8_SB(0, 0), cB, voffB); PG8_STAGE(PG8_SB(0, 1), cB + hstep, voffB); PG8_STAGE(PG8_SA(0, 0), cA, voffA); PG8_STAGE(PG8_SA(0, 1), cA + hstep, voffA);
        if (wr == 1) PG8_BAR;
        PG8_WAIT_V(2); PG8_BAR;
        PG8_STAGE(PG8_SB(1, 0), cB + kstep, voffB); PG8_STAGE(PG8_SA(1, 0), cA + kstep, voffA); PG8_STAGE(PG8_SB(1, 1), cB + hstep + kstep, voffB);
        PG8_WAIT_V(6); PG8_BAR;
    } else {
        PG8_STAGE(PG8_SB(0, 0), cB, voffB); PG8_STAGE(PG8_SA(0, 0), cA, voffA); PG8_STAGE(PG8_SB(0, 1), cB + hstep, voffB); PG8_STAGE(PG8_SA(0, 1), cA + hstep, voffA);
        if (wr == 1) PG8_BAR;
        PG8_WAIT_V(4); PG8_BAR;
        PG8_STAGE(PG8_SB(1, 0), cB + kstep, voffB); PG8_STAGE(PG8_SA(1, 0), cA + kstep, voffA); PG8_STAGE(PG8_SB(1, 1), cB + hstep + kstep, voffB);
        PG8_WAIT_V(6); PG8_BAR;
    }
    for (;;) {
        const bool has_next = S.next(ui + 1, nxt);
        const char* nA = has_next ? (const char*)g.A + (size_t)nxt.pm * tstep : cA; const char* nB = has_next ? (const char*)g.Bt + (size_t)nxt.pn * tstep : cB;
        for (int t = 0; t < nt; t += 2) {
            const bool last = (t == nt - 2);
            const char* a1 = cA + (size_t)(t + 1) * kstep;
            const char* a2 = last ? nA : cA + (size_t)(t + 2) * kstep; const char* b2 = last ? nB : cB + (size_t)(t + 2) * kstep;
            const char* a3 = a2 + kstep; const char* b3 = b2 + kstep;
            if (last && has_next) S.a_ready(nxt);
            if constexpr (SP2) {
            PG8_LDB(B0, 0, 0); PG8_LDB(B1, 0, 1); PG8_SCHED; PG8_LDA(At, 0, 0); PG8_STAGE(PG8_SA(1, 1), a1 + hstep, voffA);
            PG8_WAIT_V(8); PG8_WAIT_L(0); PG8_BAR; PG8_MMA(0, 0, At, B0); PG8_MMA(0, 1, At, B1); PG8_BAR; PG8_SCHED;
            PG8_LDA(At, 0, 1); PG8_STAGE(PG8_SB(0, 0), b2, voffB); PG8_STAGE(PG8_SB(0, 1), b2 + hstep, voffB); PG8_STAGE(PG8_SA(0, 0), a2, voffA);
            PG8_WAIT_V(8); PG8_WAIT_L(0); PG8_BAR; PG8_MMA(1, 0, At, B0); PG8_MMA(1, 1, At, B1); PG8_BAR; PG8_SCHED;
            PG8_LDB(B0, 1, 0); PG8_LDB(B1, 1, 1); PG8_SCHED; PG8_LDA(At, 1, 0); PG8_STAGE(PG8_SA(0, 1), a2 + hstep, voffA);
            PG8_WAIT_V(8); PG8_WAIT_L(0); PG8_BAR; PG8_MMA(0, 0, At, B0); PG8_MMA(0, 1, At, B1); PG8_BAR; PG8_SCHED;
            PG8_LDA(At, 1, 1); PG8_STAGE(PG8_SB(1, 0), b3, voffB); PG8_STAGE(PG8_SB(1, 1), b3 + hstep, voffB); PG8_STAGE(PG8_SA(1, 0), a3, voffA);
            PG8_WAIT_V(8); PG8_WAIT_L(0); PG8_BAR; PG8_MMA(1, 0, At, B0); PG8_MMA(1, 1, At, B1); PG8_BAR; PG8_SCHED;
            } else {
            PG8_LDB(B0, 0, 0); PG8_SCHED; PG8_LDA(At, 0, 0); PG8_STAGE(PG8_SA(1, 1), a1 + hstep, voffA);
            PG8_WAIT_L(8); PG8_BAR; PG8_WAIT_L(0); PG8_MMA(0, 0, At, B0); PG8_BAR; PG8_SCHED;
            PG8_LDB(B1, 0, 1); PG8_STAGE(PG8_SB(0, 0), b2, voffB);
            PG8_BAR; PG8_WAIT_L(0); PG8_MMA(0, 1, At, B1); PG8_BAR;
            PG8_LDA(At, 0, 1); PG8_STAGE(PG8_SA(0, 0), a2, voffA);
            PG8_BAR; PG8_WAIT_L(0); PG8_MMA(1, 0, At, B0); PG8_BAR; PG8_SCHED;
            PG8_STAGE(PG8_SB(0, 1), b2 + hstep, voffB);
            PG8_WAIT_V(6); PG8_BAR; PG8_MMA(1, 1, At, B1); PG8_BAR;
            PG8_LDB(B0, 1, 0); PG8_SCHED; PG8_LDA(At, 1, 0); PG8_STAGE(PG8_SA(0, 1), a2 + hstep, voffA);
            PG8_WAIT_L(8); PG8_BAR; PG8_WAIT_L(0); PG8_MMA(0, 0, At, B0); PG8_BAR; PG8_SCHED;
            PG8_LDB(B1, 1, 1); PG8_STAGE(PG8_SB(1, 0), b3, voffB);
            PG8_BAR; PG8_WAIT_L(0); PG8_MMA(0, 1, At, B1); PG8_BAR;
            PG8_LDA(At, 1, 1); PG8_STAGE(PG8_SA(1, 0), a3, voffA);
            PG8_BAR; PG8_WAIT_L(0); PG8_MMA(1, 0, At, B0); PG8_BAR; PG8_SCHED;
            PG8_STAGE(PG8_SB(1, 1), b3 + hstep, voffB);
            PG8_WAIT_V(6); PG8_BAR; PG8_MMA(1, 1, At, B1); PG8_BAR;
            }
        }
        if constexpr (ALIGN_EPI) { if (wr == 0) PG8_BAR; }
        if constexpr (!Epi::AFTER_DRAIN) { E(acc, cur, wr, wc, fr, fq); S.done(cur); }
        if (!has_next) break;
#pragma unroll
        for (int a = 0; a < 2; ++a)
#pragma unroll
            for (int b = 0; b < 2; ++b)
#pragma unroll
                for (int m = 0; m < 4; ++m)
#pragma unroll
                    for (int n = 0; n < 2; ++n) acc[a][b][m][n] = (f32x4){0.f, 0.f, 0.f, 0.f};
        cur = nxt; cA = nA; cB = nB; ++ui;
        if constexpr (ALIGN_EPI) { if (wr == 1) PG8_BAR; }
    }
    PG8_WAIT_V(0);
    if constexpr (!ALIGN_EPI) { if (wr == 0) PG8_BAR; }
    PG8_BAR;
    if constexpr (Epi::AFTER_DRAIN) { E.fused(acc, cur, wr, wc, fr, fq, lds, wid, lane); S.done(cur); }
#undef PG8_SA
#undef PG8_SB
#undef PG8_STAGE
#undef PG8_LDA
#undef PG8_LDB
#undef PG8_MMA
#undef PG8_WAIT_V
#undef PG8_WAIT_L
#undef PG8_BAR
#undef PG8_SCHED
}
}
namespace pg8 {
__device__ __forceinline__ unsigned bf1(float x) { return cvt_pk_bf16(x, x) & 0xffffu; }
constexpr float RMS_EPS = 1e-6f;
__device__ __forceinline__ float rstd4(const float* ssp, int row) {
    const f32x4 q = *(const f32x4*)(ssp + (unsigned)(row * 4));
    const float s = (q[0] + q[1]) + (q[2] + q[3]);
    return 1.0f / sqrtf(s * (1.0f / 1024.0f) + RMS_EPS);
}
template <int CTRL> __device__ __forceinline__ float dppf(float old, float src) {
    return __builtin_bit_cast(float, __builtin_amdgcn_update_dpp(__builtin_bit_cast(int, old), __builtin_bit_cast(int, src), CTRL, 0xf, 0xf, false));
}

struct EpiKV {
    static constexpr bool PERM = true, AFTER_DRAIN = false;
    const float* ssm;
    bf16_t* MK;
    bf16_t* MVT;
    __device__ __forceinline__ void operator()(const f32x4 (&acc)[2][2][4][2], const Unit& u, int wr, int wc, int fr_, int fq_) const {
        int fr = fr_, fq = fq_; asm volatile("" : "+v"(fr), "+v"(fq));
        const int l = u.pn >> 2, p4 = u.pn & 3;
        const int row0 = u.pm * BM + wr * 64 + fr, cl0 = wc * 32 + 8 * fq;
#pragma unroll
        for (int ai = 0; ai < 2; ++ai)
#pragma unroll
            for (int m = 0; m < 4; ++m) {
                const int row = row0 + ai * HALF + m * 16;
                const float rs = 1.0f / sqrtf(ssm[row] * (1.0f / 1024.0f) + RMS_EPS);
                if (p4 < 2) {
                    bf16_t* rowp = MK + ((size_t)l * 2048 + row) * 512 + p4 * 256 + cl0;
#pragma unroll
                    for (int bj = 0; bj < 2; ++bj) { const f32x4 v0 = acc[ai][bj][m][0] * rs, v1 = acc[ai][bj][m][1] * rs;
                        u32x4 w; w.x = cvt_pk_bf16(v0[0], v0[1]); w.y = cvt_pk_bf16(v0[2], v0[3]); w.z = cvt_pk_bf16(v1[0], v1[1]); w.w = cvt_pk_bf16(v1[2], v1[3]);
                        *(u32x4*)(rowp + bj * HALF) = w; }
                } else {
                    const int b = row >> 8, key = row & 255;
#pragma unroll
                    for (int bj = 0; bj < 2; ++bj)
#pragma unroll
                        for (int n = 0; n < 2; ++n)
#pragma unroll
                            for (int j = 0; j < 4; ++j) { const int c = (p4 - 2) * 256 + bj * HALF + cl0 + 4 * n + j, h = c >> 7, d = c & 127;
                                MVT[((((size_t)l * 8 + b) * 4 + h) * 128 + d) * 256 + key] = (bf16_t)bf1(acc[ai][bj][m][n][j] * rs); }
                }
            }
    }
};

struct EpiIn0 {
    static constexpr bool PERM = true, AFTER_DRAIN = false;
    const float* ssp; bf16_t *XBR, *GBR, *CAT;
    __device__ __forceinline__ void operator()(const f32x4 (&acc)[2][2][4][2], const Unit& u, int wr, int wc, int fr_, int fq_) const {
        int fr = fr_, fq = fq_; asm volatile("" : "+v"(fr), "+v"(fq));
        const int seg = u.pn >> 2; bf16_t* base; int pitch, colt;
        if (seg == 0) { base = XBR; pitch = 1024; colt = u.pn * 256; } else if (seg == 1) { base = GBR; pitch = 1024; colt = (u.pn - 4) * 256; } else { base = CAT + 1024; pitch = 1536; colt = (u.pn - 8) * 256; }
        const int row0 = u.pm * BM + wr * 64 + fr, col0 = colt + wc * 32 + 8 * fq;
#pragma unroll
        for (int ai = 0; ai < 2; ++ai)
#pragma unroll
            for (int m = 0; m < 4; ++m) { const int row = row0 + ai * HALF + m * 16; const float rs = rstd4(ssp, row);
                bf16_t* rowp = base + (size_t)row * pitch + col0;
#pragma unroll
                for (int bj = 0; bj < 2; ++bj) { const f32x4 v0 = acc[ai][bj][m][0] * rs, v1 = acc[ai][bj][m][1] * rs;
                    u32x4 w; w.x = cvt_pk_bf16(v0[0], v0[1]); w.y = cvt_pk_bf16(v0[2], v0[3]); w.z = cvt_pk_bf16(v1[0], v1[1]); w.w = cvt_pk_bf16(v1[2], v1[3]);
                    *(u32x4*)(rowp + bj * HALF) = w; } }
    }
};

struct EpiOut {
    static constexpr bool PERM = false, AFTER_DRAIN = true;
    const float* base; float* out; bf16_t* xb16; float* ssp;
    __device__ __forceinline__ void fused(f32x4 (&acc)[2][2][4][2], const Unit& u, int wr, int wc, int fr, int fq, PG8_LAS unsigned char* lds, int wid, int lane) const {
        typedef unsigned u32x2v __attribute__((ext_vector_type(2)));
        PG8_LAS float* P = (PG8_LAS float*)lds;
        const int col0 = u.pn * BM + wc * 32 + 4 * fq;
#pragma unroll
        for (int ai = 0; ai < 2; ++ai)
#pragma unroll
            for (int m = 0; m < 4; ++m) { const int r = ai * HALF + wr * 64 + m * 16 + fr; const size_t off = (size_t)(u.pm * BM + r) * 1024 + col0; float ss = 0.f;
#pragma unroll
                for (int bj = 0; bj < 2; ++bj)
#pragma unroll
                    for (int n = 0; n < 2; ++n) { const f32x4 bs = *(const f32x4*)(base + off + bj * HALF + n * 16); const f32x4 v = bs + acc[ai][bj][m][n];
                        *(f32x4*)(out + off + bj * HALF + n * 16) = v; ss += (v[0] * v[0] + v[1] * v[1]) + (v[2] * v[2] + v[3] * v[3]);
                        u32x2v w; w.x = cvt_pk_bf16(v[0], v[1]); w.y = cvt_pk_bf16(v[2], v[3]); *(u32x2v*)(xb16 + off + bj * HALF + n * 16) = w; }
                ss += __shfl_xor(ss, 16); ss += __shfl_xor(ss, 32);
                if (fq == 0) P[r * 4 + wc] = ss;
                asm volatile("" ::: "memory"); }
        asm volatile("s_waitcnt lgkmcnt(0)" ::: "memory"); __builtin_amdgcn_s_barrier(); asm volatile("" ::: "memory");
        const int tid = wid * 64 + lane;
        if (tid < 256) ssp[(size_t)(u.pm * BM + tid) * 4 + u.pn] = (P[tid * 4 + 0] + P[tid * 4 + 1]) + (P[tid * 4 + 2] + P[tid * 4 + 3]);
        asm volatile("s_waitcnt lgkmcnt(0)" ::: "memory"); __builtin_amdgcn_s_barrier(); asm volatile("" ::: "memory");
    }
};

struct EpiUp {
    static constexpr bool PERM = true, AFTER_DRAIN = false;
    const float* ssp; const float* cw; const float* cb; bf16_t* ACT; float* HALO;
    __device__ __forceinline__ void operator()(const f32x4 (&acc)[2][2][4][2], const Unit& u, int wr, int wc, int fr_, int fq_) const {
        int fr = fr_, fq = fq_; asm volatile("" : "+v"(fr), "+v"(fq));
        const int chb = u.pn * 128 + wc * 32 + 8 * fq;
        const int row0 = u.pm * BM + wr * 64 + fr;
        float rs[2][4];
#pragma unroll
        for (int ai = 0; ai < 2; ++ai) {
#pragma unroll
            for (int m = 0; m < 4; ++m) rs[ai][m] = rstd4(ssp, row0 + ai * HALF + m * 16);
            asm volatile("" : "+v"(rs[ai][0]), "+v"(rs[ai][1]), "+v"(rs[ai][2]), "+v"(rs[ai][3]));
            __builtin_amdgcn_sched_barrier(0); }
#pragma unroll
        for (int n = 0; n < 2; ++n)
#pragma unroll
            for (int jp = 0; jp < 2; ++jp) {
                const unsigned uc = (unsigned)(chb + 4 * n + 2 * jp);
                float wg[2][4], wv[2][4];
#pragma unroll
                for (int jj = 0; jj < 2; ++jj) {
                    wg[jj][0] = cw[uc + jj]; wg[jj][1] = cw[uc + jj + 5632u]; wg[jj][2] = cw[uc + jj + 2u * 5632u]; wg[jj][3] = cb[uc + jj];
                    wv[jj][0] = cw[uc + jj + 2816u]; wv[jj][1] = cw[uc + jj + 5632u + 2816u]; wv[jj][2] = cw[uc + jj + 2u * 5632u + 2816u]; wv[jj][3] = cb[uc + jj + 2816u]; }
#pragma unroll
                for (int ai = 0; ai < 2; ++ai) {
                    const int chunk = u.pm * 4 + ai * 2 + wr;
                    float res[4][2];
#pragma unroll
                    for (int jj = 0; jj < 2; ++jj) {
                        const int j = 2 * jp + jj;
                        float ug[4], uv[4];
#pragma unroll
                        for (int m = 0; m < 4; ++m) { ug[m] = acc[ai][0][m][n][j] * rs[ai][m]; uv[m] = acc[ai][1][m][n][j] * rs[ai][m]; }
                        if (fr < 2) { float* hp = HALO + (unsigned)((chunk * 4 + fr) * 2 * 2816) + (uc + jj); hp[0] = ug[0]; hp[2816] = uv[0]; }
                        if (fr >= 14) { float* hp = HALO + (unsigned)((chunk * 4 + (fr - 12)) * 2 * 2816) + (uc + jj); hp[0] = ug[3]; hp[2816] = uv[3]; }
#pragma unroll
                        for (int m = 0; m < 4; ++m) {
                            float og1 = 0.f, og2 = 0.f, ov1 = 0.f, ov2 = 0.f;
                            if (m > 0) { og1 = dppf<0x121>(0.f, ug[m - 1]); og2 = dppf<0x122>(0.f, ug[m - 1]); ov1 = dppf<0x121>(0.f, uv[m - 1]); ov2 = dppf<0x122>(0.f, uv[m - 1]); }
                            const float g1 = dppf<0x111>(og1, ug[m]), g2 = dppf<0x112>(og2, ug[m]), v1 = dppf<0x111>(ov1, uv[m]), v2 = dppf<0x112>(ov2, uv[m]);
                            const float yg = wg[jj][3] + wg[jj][0] * g2 + wg[jj][1] * g1 + wg[jj][2] * ug[m];
                            const float yv = wv[jj][3] + wv[jj][0] * v2 + wv[jj][1] * v1 + wv[jj][2] * uv[m];
                            res[m][jj] = yg * __builtin_amdgcn_rcpf(1.0f + __expf(-yg)) * yv;
                        }
                    }
#pragma unroll
                    for (int m = 0; m < 4; ++m)
                        if (m > 0 || fr >= 2) *(unsigned*)(ACT + (unsigned)((row0 + ai * HALF + m * 16) * 2816) + uc) = cvt_pk_bf16(res[m][0], res[m][1]);
                    __builtin_amdgcn_sched_barrier(0);
                }
            }
    }
};

struct EpiIn1 {
    static constexpr bool PERM = false, AFTER_DRAIN = false;
    const float* ssp; const float *cosA, *sinA, *cosI, *sinI;
    bf16_t *CAT, *KB, *VT, *IQ, *IK; float* IW;
    __device__ __forceinline__ void operator()(const f32x4 (&acc)[2][2][4][2], const Unit& u, int wr, int wc, int fr_, int fq_) const {
        typedef unsigned u32x2v __attribute__((ext_vector_type(2)));
        int fr = fr_, fq = fq_; asm volatile("" : "+v"(fr), "+v"(fq));
        const int pn = u.pn;
        const int row0 = u.pm * BM + wr * 64 + fr;
#pragma unroll
        for (int ai = 0; ai < 2; ++ai)
#pragma unroll
            for (int m = 0; m < 4; ++m) {
                const int row = row0 + ai * HALF + m * 16; const float rs = rstd4(ssp, row);
                f32x4 v[2][2];
#pragma unroll
                for (int bj = 0; bj < 2; ++bj)
#pragma unroll
                    for (int n = 0; n < 2; ++n) v[bj][n] = acc[ai][bj][m][n] * rs;
                if (pn < 8) {
                    if (wc == 0) { const f32x4 c = *(const f32x4*)(cosA + (size_t)row * 16 + 4 * fq), s = *(const f32x4*)(sinA + (size_t)row * 16 + 4 * fq);
#pragma unroll
                        for (int bj = 0; bj < 2; ++bj) { const f32x4 x1 = v[bj][0], x2 = v[bj][1]; v[bj][0] = x1 * c - x2 * s; v[bj][1] = x2 * c + x1 * s; } }
                    bf16_t* rowp = (pn < 4) ? CAT + (size_t)row * 1536 + pn * 256 : KB + (size_t)row * 1024 + (pn - 4) * 256;
#pragma unroll
                    for (int bj = 0; bj < 2; ++bj)
#pragma unroll
                        for (int n = 0; n < 2; ++n) { u32x2v w; w.x = cvt_pk_bf16(v[bj][n][0], v[bj][n][1]); w.y = cvt_pk_bf16(v[bj][n][2], v[bj][n][3]);
                            *(u32x2v*)(rowp + bj * HALF + wc * 32 + n * 16 + 4 * fq) = w; }
                } else if (pn < 12) {
                    const int b = row >> 11, s = row & 2047;
#pragma unroll
                    for (int bj = 0; bj < 2; ++bj) { const int head = (pn - 8) * 2 + bj;
#pragma unroll
                        for (int n = 0; n < 2; ++n)
#pragma unroll
                            for (int j = 0; j < 4; ++j) { const int d = wc * 32 + n * 16 + 4 * fq + j;
                                VT[(((size_t)b * 8 + head) * 128 + d) * 2048 + s] = (bf16_t)bf1(v[bj][n][j]); } }
                } else if (pn < 14) {
                    bf16_t* rowp = CAT + (size_t)row * 1536 + 1024 + (pn - 12) * 256;
#pragma unroll
                    for (int bj = 0; bj < 2; ++bj)
#pragma unroll
                        for (int n = 0; n < 2; ++n) { u32x2v w; w.x = cvt_pk_bf16(v[bj][n][0], v[bj][n][1]); w.y = cvt_pk_bf16(v[bj][n][2], v[bj][n][3]);
                            *(u32x2v*)(rowp + bj * HALF + wc * 32 + n * 16 + 4 * fq) = w; }
                } else {
                    if ((wc & 1) == 0 && !(pn == 16 && wc >= 2)) { const int fi = 4 * (fq & 1);
                        const f32x4 c = *(const f32x4*)(cosI + (size_t)row * 8 + fi), s = *(const f32x4*)(sinI + (size_t)row * 8 + fi);
#pragma unroll
                        for (int bj = 0; bj < 2; ++bj) { f32x4 p;
#pragma unroll
                            for (int j = 0; j < 4; ++j) p[j] = __shfl_xor(v[bj][0][j], 32);
                            v[bj][0] = (fq < 2) ? (v[bj][0] * c - p * s) : (v[bj][0] * c + p * s); } }
                    if (pn < 16) { bf16_t* rowp = IQ + (size_t)row * 512 + (pn - 14) * 256;
#pragma unroll
                        for (int bj = 0; bj < 2; ++bj)
#pragma unroll
                            for (int n = 0; n < 2; ++n) { u32x2v w; w.x = cvt_pk_bf16(v[bj][n][0], v[bj][n][1]); w.y = cvt_pk_bf16(v[bj][n][2], v[bj][n][3]);
                                *(u32x2v*)(rowp + bj * HALF + wc * 32 + n * 16 + 4 * fq) = w; }
                    } else {
                        if (wc < 2) {
#pragma unroll
                            for (int n = 0; n < 2; ++n) { u32x2v w; w.x = cvt_pk_bf16(v[0][n][0], v[0][n][1]); w.y = cvt_pk_bf16(v[0][n][2], v[0][n][3]);
                                *(u32x2v*)(IK + (size_t)row * 64 + wc * 32 + n * 16 + 4 * fq) = w; }
                        } else if (wc == 2 && fq < 2) { *(f32x4*)(IW + (size_t)row * 8 + 4 * fq) = v[0][0] * 0.35355339059327373f; }
                    }
                }
                __builtin_amdgcn_sched_barrier(0);
            }
    }
};
}
constexpr int NWAVES = 8;
#ifndef MK_N_LAUNCHES
#define MK_N_LAUNCHES 1
#endif
constexpr int N_PHASES = 15;
constexpr int NB = 8, SEQ = 2048, DM = 1024, M = NB * SEQ, MEMT = 256, MMEM = NB * MEMT;
constexpr int DFF = 2816, NUP = 2 * DFF, NIN0 = 2560, NIN1 = 4352, NIN1_SRC = 4168, KCAT = 1536;
constexpr size_t MiB = 1u << 20;
constexpr size_t WS_CTL = 0, CTL_ZERO_BYTES = 64 * 1024;
constexpr size_t WS_WKV = 1 * MiB, WS_WIN0 = 5 * MiB, WS_WOUT0 = 10 * MiB, WS_WOUT1 = 13 * MiB, WS_WUP0 = 16 * MiB, WS_WUP1 = 27 * MiB;
constexpr size_t WS_WDN0 = 38 * MiB, WS_WDN1 = WS_WDN0 + 11 * MiB / 2, WS_WIN1 = 49 * MiB;
constexpr size_t WS_XB16 = 58 * MiB, WS_MEM16 = 90 * MiB, WS_MK = 94 * MiB, WS_MVT = 98 * MiB, WS_SSP = 102 * MiB, WS_SSM = WS_SSP + 512 * 1024;
constexpr size_t WS_COSA = 103 * MiB, WS_SINA = 104 * MiB, WS_COSI = 105 * MiB, WS_SINI = WS_COSI + 512 * 1024, WS_MASK = 106 * MiB, WS_BIG = 110 * MiB;
constexpr size_t WS_XBR = WS_BIG, WS_GBR = WS_BIG + 32 * MiB, WS_CAT0 = WS_BIG + 64 * MiB;
constexpr size_t WS_CAT1 = WS_BIG, WS_KB = WS_BIG + 48 * MiB, WS_VT = WS_BIG + 80 * MiB, WS_IQ = WS_BIG + 112 * MiB, WS_IK = WS_BIG + 128 * MiB, WS_IW = WS_BIG + 130 * MiB;
constexpr size_t WS_ACT = WS_BIG, WS_HALO = WS_BIG + 88 * MiB;
constexpr size_t WS_END = WS_BIG + 131 * MiB;
static_assert(WS_WIN1 + (size_t)NIN1 * DM * 2 <= WS_XB16 && WS_HALO + (size_t)256 * 4 * 2 * DFF * 4 <= WS_END && WS_END <= 256 * MiB, "d_ws map");
constexpr int CW_BAR = 1024;

constexpr int RING_OFF = 0, RING_BYTES = 131072;
constexpr int LDSCTL_OFF = RING_BYTES, MISC_OFF = LDSCTL_OFF + 320;
constexpr int LDS_BYTES = 147456;
#define GAS __attribute__((address_space(1)))
#define LAS __attribute__((address_space(3)))
typedef unsigned short bf16;
typedef unsigned v4u __attribute__((ext_vector_type(4)));
typedef float f32x4 __attribute__((ext_vector_type(4)));
typedef short bf16x8 __attribute__((ext_vector_type(8)));
typedef GAS unsigned gu32;
typedef GAS unsigned long long gu64;
#define RLX_AGENT __ATOMIC_RELAXED, __HIP_MEMORY_SCOPE_AGENT
#define LDS_WAIT() asm volatile("s_waitcnt lgkmcnt(0)" ::: "memory")
#define VM_WAIT() asm volatile("s_waitcnt vmcnt(0)" ::: "memory")
__device__ __forceinline__ unsigned long long rt() { return __builtin_amdgcn_s_memrealtime(); }
__device__ __forceinline__ unsigned f2bf(float f) { unsigned u = __builtin_bit_cast(unsigned, f); return (u + 0x7fffu + ((u >> 16) & 1u)) >> 16; }
__device__ __forceinline__ unsigned pk2(float lo, float hi) { return f2bf(lo) | (f2bf(hi) << 16); }
#define XB_TMO      128
#define XB_XCNT(j)  (256  + 64 * (j))
#define XB_XSUB(j)  (1280 + 64 * (j))
#define XB_XGEN(j)  (2304 + 64 * (j))
#define XB_TOP      3328
#define XB_TOPGEN   3392
#define XCD_BAR_WORDS 3456
#define XB_SPIN_CAP (1u << 18)

__device__ __forceinline__ unsigned xb_ld(unsigned* p)              { return __hip_atomic_load(p, __ATOMIC_RELAXED, __HIP_MEMORY_SCOPE_AGENT); }
__device__ __forceinline__ unsigned xb_add(unsigned* p, unsigned v) { return __hip_atomic_fetch_add(p, v, __ATOMIC_RELAXED, __HIP_MEMORY_SCOPE_AGENT); }
__device__ __forceinline__ unsigned xb_xcc_id() { return (unsigned)__builtin_amdgcn_s_getreg((3 << 11) | 20) & 0xFu; }
#define XB_SPIN(cond, bar) do { unsigned _sp = 0; while (cond) { __builtin_amdgcn_s_sleep(1); \
    if ((++_sp & 255u) == 0u) { if (xb_ld(&(bar)[XB_TMO])) break; if (_sp > XB_SPIN_CAP) { atomicAdd(&(bar)[XB_TMO], 1u); break; } } } } while (0)

struct XcdBarrier {
    unsigned* bar; unsigned x;
    volatile LAS unsigned* st;
};

__device__ __forceinline__ XcdBarrier xcd_barrier_post(unsigned* bar, volatile LAS unsigned* st) {
    XcdBarrier b; b.bar = bar; b.x = xb_xcc_id(); b.st = st;
    if (threadIdx.x == 0) (void)xb_add(&bar[XB_XCNT(b.x)], 1u);
    return b;
}
__device__ __forceinline__ void xcd_barrier_complete(unsigned* bar, unsigned x, unsigned& nloc, unsigned& nx) {
    const unsigned G = gridDim.x * gridDim.y * gridDim.z;
    unsigned sum, cnt, mine, sp = 0u;
    for (;;) {
        sum = 0u; cnt = 0u; mine = 0u;
#pragma unroll
        for (unsigned j = 0; j < 16; ++j) { const unsigned c = xb_ld(&bar[XB_XCNT(j)]); sum += c; cnt += (c > 0u) ? 1u : 0u; mine = (j == x) ? c : mine; }
        if (sum == G) break;
        __builtin_amdgcn_s_sleep(1);
        if ((++sp & 255u) == 0u) { if (xb_ld(&bar[XB_TMO])) break; if (sp > XB_SPIN_CAP) { atomicAdd(&bar[XB_TMO], 1u); break; } }
    }
    nloc = mine > 0u ? mine : 1u; nx = cnt > 0u ? cnt : 1u;
}

__device__ __forceinline__ void xcd_barrier(const XcdBarrier& b) {
    asm volatile("s_waitcnt vmcnt(0)" ::: "memory");
    __syncthreads();
    if (threadIdx.x == 0) {
        unsigned* bar = b.bar;
        __builtin_amdgcn_s_waitcnt(0);
        unsigned nloc = b.st[0], nx = b.st[1];
        if (nloc == 0u) { xcd_barrier_complete(bar, b.x, nloc, nx); b.st[0] = nloc; b.st[1] = nx; }
        const unsigned old = xb_add(&bar[XB_XSUB(b.x)], 1u);
        const unsigned gen = old / nloc;
        if (old + 1u == (gen + 1u) * nloc) {
            __builtin_amdgcn_fence(__ATOMIC_RELEASE, "agent");
            asm volatile("s_waitcnt vmcnt(0)" ::: "memory");
            const unsigned og = xb_add(&bar[XB_TOP], 1u);
            const unsigned tg = og / nx;
            if (og + 1u == (tg + 1u) * nx) xb_add(&bar[XB_TOPGEN], 1u);
            else XB_SPIN(xb_ld(&bar[XB_TOPGEN]) == tg, bar);
            __builtin_amdgcn_fence(__ATOMIC_ACQUIRE, "agent");
            xb_add(&bar[XB_XGEN(b.x)], 1u);
            asm volatile("s_waitcnt vmcnt(0)" ::: "memory");
        } else {
            XB_SPIN(xb_ld(&bar[XB_XGEN(b.x)]) == gen, bar);
            __builtin_amdgcn_fence(__ATOMIC_ACQUIRE, "agent");
            asm volatile("s_waitcnt vmcnt(0)" ::: "memory");
        }
    }
    __syncthreads();
}
typedef float f32x16 __attribute__((ext_vector_type(16)));
typedef unsigned u32x2 __attribute__((ext_vector_type(2)));
using pg8::cvt_pk_bf16;
__device__ __forceinline__ float wave_sum(float v) {
#pragma unroll
    for (int o = 1; o < 64; o <<= 1) v += __shfl_xor(v, o);
    return v;
}
__device__ __forceinline__ unsigned cvt_pk_bf16_mfma(float lo, float hi) { unsigned r; asm volatile("v_cvt_pk_bf16_f32 %0, %1, %2\n\ts_nop 1" : "=v"(r) : "v"(lo), "v"(hi)); return r; }
__device__ __forceinline__ bf16x8 pack8(const float* p) { v4u w; w.x = cvt_pk_bf16_mfma(p[0], p[1]); w.y = cvt_pk_bf16_mfma(p[2], p[3]); w.z = cvt_pk_bf16_mfma(p[4], p[5]); w.w = cvt_pk_bf16_mfma(p[6], p[7]); return __builtin_bit_cast(bf16x8, w); }
__device__ __forceinline__ float bf2f(bf16 v) { return __builtin_bit_cast(float, (unsigned)v << 16); }
__device__ __forceinline__ float sigmoidf_(float x) { return __builtin_amdgcn_rcpf(1.0f + __expf(-x)); }

__device__ __forceinline__ void p0_transpose_item(const float* W, int Nsrc, const float* g, bf16* WT, int K, int k0, int n0, int s0, int nvalid, LAS bf16* scr, int lane) {
    float v[64];
    const float* wp = W + (size_t)k0 * Nsrc + s0 + lane;
    const bool ok = lane < nvalid;
#pragma unroll
    for (int i = 0; i < 64; ++i) v[i] = ok ? wp[(size_t)i * Nsrc] : 0.f;
    if (g) {
#pragma unroll
        for (int i = 0; i < 64; ++i) v[i] *= g[k0 + i];
    }
#pragma unroll
    for (int i = 0; i < 64; ++i) scr[i * 66 + lane] = (bf16)pg8::bf1(v[i]);
    LDS_WAIT(); asm volatile("" ::: "memory");
    const int c = lane & 7;
#pragma unroll
    for (int j = 0; j < 8; ++j) { const int n = (lane >> 3) + 8 * j; const LAS bf16* s = scr + (8 * c) * 66 + n;
        v4u o; o.x = (unsigned)s[0] | ((unsigned)s[66] << 16); o.y = (unsigned)s[2 * 66] | ((unsigned)s[3 * 66] << 16);
        o.z = (unsigned)s[4 * 66] | ((unsigned)s[5 * 66] << 16); o.w = (unsigned)s[6 * 66] | ((unsigned)s[7 * 66] << 16);
        *(v4u*)(WT + (size_t)(n0 + n) * K + k0 + 8 * c) = o; }
    LDS_WAIT(); asm volatile("" ::: "memory");
}
struct Ptrs {
    const float *x, *mem; const int* pos; const float *norm_mix, *norm_ffn, *mem_norm, *final_norm, *w_mem_kv, *w_ffn_up, *ffn_conv_w, *ffn_conv_b, *w_ffn_down;
    const float *lru_w_in, *lru_conv_w, *lru_conv_b, *lru_w_a, *lru_b_a, *lru_w_x, *lru_b_x, *lru_lambda, *lru_w_out, *dsa_w_in, *dsa_w_out;
    float* out; unsigned char* ws;
};
__device__ __forceinline__ void p0_prologue(const Ptrs& P, LAS unsigned char* lds, int gw, int NGW, int wave, int lane) {
    LAS bf16* scr = (LAS bf16*)(lds + wave * 16384);
    unsigned char* ws = P.ws;
    constexpr int I_KV = 16 * 32, I_IN0 = 16 * 40, I_OUT = 24 * 16, I_UP = 16 * 88, I_DN = 44 * 16, I_IN1 = 16 * 68;
    constexpr int NITEMS = I_KV + I_IN0 + 2 * I_OUT + 2 * I_UP + 2 * I_DN + I_IN1;
    for (int it = gw; it < NITEMS; it += NGW) {
        int r = it;
        if (r < I_KV) { const int kb = r / 32, nb = r % 32, l = nb / 16;
            p0_transpose_item(P.w_mem_kv + (size_t)l * 1024 * 1024, 1024, P.mem_norm, (bf16*)(ws + WS_WKV), 1024, kb * 64, nb * 64, (nb % 16) * 64, 64, scr, lane); continue; } r -= I_KV;
        if (r < I_IN0) { const int kb = r / 40, nb = r % 40;
            p0_transpose_item(P.lru_w_in, NIN0, P.norm_mix, (bf16*)(ws + WS_WIN0), 1024, kb * 64, nb * 64, nb * 64, 64, scr, lane); continue; } r -= I_IN0;
        if (r < 2 * I_OUT) { const int l = r / I_OUT, q = r % I_OUT, kb = q / 16, nb = q % 16;
            p0_transpose_item(l ? P.dsa_w_out : P.lru_w_out, 1024, nullptr, (bf16*)(ws + (l ? WS_WOUT1 : WS_WOUT0)), KCAT, kb * 64, nb * 64, nb * 64, 64, scr, lane); continue; } r -= 2 * I_OUT;
        if (r < 2 * I_UP) { const int l = r / I_UP, q = r % I_UP, kb = q / 88, nb = q % 88;
            const int tile = nb / 4, half = (nb % 4) / 2, j0 = (nb % 2) * 64;
            p0_transpose_item(P.w_ffn_up + (size_t)l * 1024 * NUP, NUP, P.norm_ffn + l * 1024, (bf16*)(ws + (l ? WS_WUP1 : WS_WUP0)), 1024, kb * 64, nb * 64, half * DFF + tile * 128 + j0, 64, scr, lane); continue; } r -= 2 * I_UP;
        if (r < 2 * I_DN) { const int l = r / I_DN, q = r % I_DN, kb = q / 16, nb = q % 16;
            p0_transpose_item(P.w_ffn_down + (size_t)l * DFF * 1024, 1024, nullptr, (bf16*)(ws + (l ? WS_WDN1 : WS_WDN0)), DFF, kb * 64, nb * 64, nb * 64, 64, scr, lane); continue; } r -= 2 * I_DN;
        { const int kb = r / 68, nb = r % 68, n0 = nb * 64; int s0, nv = 64;
            if (n0 < 3072) s0 = n0; else if (n0 < 3584) s0 = 3656 + (n0 - 3072); else if (n0 < 4096) s0 = 3072 + (n0 - 3584); else if (n0 < 4160) s0 = 3584 + (n0 - 4096);
            else if (n0 == 4160) { s0 = 3648; nv = 8; } else { s0 = 0; nv = 0; }
            p0_transpose_item(P.dsa_w_in, NIN1_SRC, P.norm_mix + 1024, (bf16*)(ws + WS_WIN1), 1024, kb * 64, n0, s0, nv, scr, lane); }
    }
    float* ssp = (float*)(ws + WS_SSP); float* ssm = (float*)(ws + WS_SSM);
    for (int m = gw; m < M + MMEM; m += NGW) {
        const bool is_x = m < M; const int r = is_x ? m : m - M;
        const f32x4* xr = (const f32x4*)((is_x ? P.x : P.mem) + (size_t)r * DM) + lane;
        unsigned long long* o8 = (unsigned long long*)((bf16*)(ws + (is_x ? WS_XB16 : WS_MEM16)) + (size_t)r * DM) + lane;
        float s = 0.f;
#pragma unroll
        for (int j = 0; j < 4; ++j) { const f32x4 v = xr[64 * j]; s += (v.x * v.x + v.y * v.y) + (v.z * v.z + v.w * v.w);
            o8[64 * j] = (unsigned long long)cvt_pk_bf16(v.x, v.y) | ((unsigned long long)cvt_pk_bf16(v.z, v.w) << 32); }
        s = wave_sum(s);
        if (lane == 0) { if (is_x) { *(f32x4*)(ssp + (size_t)r * 4) = (f32x4){s, 0.f, 0.f, 0.f}; } else ssm[r] = s; }
    }
    float *cosA = (float*)(ws + WS_COSA), *sinA = (float*)(ws + WS_SINA), *cosI = (float*)(ws + WS_COSI), *sinI = (float*)(ws + WS_SINI);
    for (int e = gw * 64 + lane; e < M * 24; e += NGW * 64) {
        const int row = e / 24, i = e % 24; const double p = (double)P.pos[row];
        if (i < 16) { const double a = p * pow(500000.0, -(double)(2 * i) / 32.0); cosA[row * 16 + i] = (float)cos(a); sinA[row * 16 + i] = (float)sin(a); }
        else { const int ii = i - 16; const double a = p * pow(500000.0, -(double)(2 * ii) / 16.0); cosI[row * 8 + ii] = (float)cos(a); sinI[row * 8 + ii] = (float)sin(a); }
    }
}
template <bool MASKED>
__device__ __forceinline__ void attn_block(LAS unsigned char* lds, const bf16* Q, int qpitch, const bf16* K, int kpitch, const bf16* VT, int vtpitch, int nt, int last_tile,
                                           const unsigned* mask, bf16* O, int opitch, int tid, int lane) {
    const int qrow = lane & 31, hi = lane >> 5;
    bf16x8 qf[8];
#pragma unroll
    for (int s = 0; s < 8; ++s) qf[s] = *(const bf16x8*)(Q + (size_t)qrow * qpitch + 16 * s + 8 * hi);
    f32x16 oacc[4];
#pragma unroll
    for (int dt = 0; dt < 4; ++dt)
#pragma unroll
        for (int r = 0; r < 16; ++r) oacc[dt][r] = 0.f;
    float mrun = -1e30f, lrun = 0.f;
    const float cs = 1.4426950408889634f * 0.08838834764831845f;
    const int kkey = tid >> 4, kch = tid & 15, vd = tid >> 2, vch = tid & 3;
    const unsigned kdst = (unsigned)(kkey * 256 + ((kch ^ (kkey & 15)) << 4)), vdst = (unsigned)(16384 + vd * 64 + ((vch ^ ((vd >> 2) & 3)) << 4));
    const bf16* kg = K + (size_t)kkey * kpitch + kch * 8;
    const bf16* vg = VT + (size_t)vd * vtpitch + vch * 8;
    const int i5 = lane & 31, keyl = (i5 & ~12) | ((i5 & 4) << 1) | ((i5 & 8) >> 1);
    const unsigned kbase = (unsigned)(keyl * 256), kx = (unsigned)(keyl & 15), vbase = (unsigned)(16384 + i5 * 64), vx = (unsigned)((i5 >> 2) & 3);
    v4u kr = *(const v4u*)kg, vr = *(const v4u*)vg;
    __syncthreads();
    *(LAS v4u*)(lds + kdst) = kr; *(LAS v4u*)(lds + vdst) = vr;
    unsigned mw_next = 0xffffffffu;
    if (MASKED) mw_next = mask[(size_t)qrow * 64];
    LDS_WAIT(); __syncthreads();
    for (int kt = 0; kt < nt; ++kt) {
        const unsigned bo = (unsigned)((kt & 1) * 8192);
        const bool more = kt + 1 < nt;
        if (more) { kr = *(const v4u*)(kg + (size_t)(kt + 1) * 32 * kpitch); vr = *(const v4u*)(vg + (kt + 1) * 32); }
        unsigned mw = mw_next;
        if (MASKED && kt + 1 <= last_tile) mw_next = mask[(size_t)qrow * 64 + kt + 1];
        if (kt <= last_tile) {
            f32x16 sacc;
#pragma unroll
            for (int r = 0; r < 16; ++r) sacc[r] = 0.f;
#pragma unroll
            for (int s = 0; s < 8; ++s) { const bf16x8 kf = *(const LAS bf16x8*)(lds + bo + kbase + ((((unsigned)(2 * s + hi)) ^ kx) << 4));
                sacc = __builtin_amdgcn_mfma_f32_32x32x16_bf16(kf, qf[s], sacc, 0, 0, 0); }
            mw >>= (8 * hi);
            float mx = -1e30f;
#pragma unroll
            for (int r = 0; r < 16; ++r) { const int sh = (r & 3) + 4 * ((r >> 2) & 1) + 16 * (r >> 3); const bool sel = !MASKED || ((mw >> sh) & 1u);
                sacc[r] = sel ? sacc[r] * cs : -1e30f; mx = fmaxf(mx, sacc[r]); }
            mx = fmaxf(mx, __shfl_xor(mx, 32));
            const float mnew = fmaxf(mrun, mx);
            const float alpha = __builtin_amdgcn_exp2f(mrun - mnew);
            mrun = mnew;
            float p[16]; float ps = 0.f;
#pragma unroll
            for (int r = 0; r < 16; ++r) { p[r] = (sacc[r] > -1e29f) ? __builtin_amdgcn_exp2f(sacc[r] - mnew) : 0.f; ps += p[r]; }
            lrun = lrun * alpha + ps;
            if (!__all(alpha == 1.0f)) {
#pragma unroll
                for (int dt = 0; dt < 4; ++dt)
#pragma unroll
                    for (int r = 0; r < 16; ++r) oacc[dt][r] *= alpha;
            }
            bf16x8 pb[2];
            pb[0] = pack8(p); pb[1] = pack8(p + 8);
#pragma unroll
            for (int dt = 0; dt < 4; ++dt)
#pragma unroll
                for (int s2 = 0; s2 < 2; ++s2) { const bf16x8 vf = *(const LAS bf16x8*)(lds + bo + vbase + (unsigned)(dt * 2048) + ((((unsigned)(2 * s2 + hi)) ^ vx) << 4));
                    oacc[dt] = __builtin_amdgcn_mfma_f32_32x32x16_bf16(vf, pb[s2], oacc[dt], 0, 0, 0); }
        }
        if (more) { *(LAS v4u*)(lds + (bo ^ 8192u) + kdst) = kr; *(LAS v4u*)(lds + (bo ^ 8192u) + vdst) = vr; }
        LDS_WAIT(); __syncthreads();
    }
    const float ltot = lrun + __shfl_xor(lrun, 32);
    const float inv = __builtin_amdgcn_rcpf(ltot);
#pragma unroll
    for (int dt = 0; dt < 4; ++dt)
#pragma unroll
        for (int g4 = 0; g4 < 4; ++g4) { u32x2 w; w.x = cvt_pk_bf16(oacc[dt][4 * g4] * inv, oacc[dt][4 * g4 + 1] * inv); w.y = cvt_pk_bf16(oacc[dt][4 * g4 + 2] * inv, oacc[dt][4 * g4 + 3] * inv);
            *(u32x2*)(O + (size_t)qrow * opitch + 32 * dt + 8 * g4 + 4 * hi) = w; }
}
__device__ __forceinline__ void memattn_block(unsigned char* ws, LAS unsigned char* lds, int l, bf16* CAT, int u, int tid, int wave, int lane) {
    const int qb = u & 7, h = (u >> 3) & 3, b = u >> 5;
    bf16* q = CAT + (size_t)(b * SEQ + qb * 256 + wave * 32) * KCAT + 1024 + h * 128;
    const bf16* k = (const bf16*)(ws + WS_MK) + ((size_t)l * MMEM + b * MEMT) * 512 + h * 128;
    const bf16* vt = (const bf16*)(ws + WS_MVT) + (((size_t)l * 8 + b) * 4 + h) * 128 * 256;
    attn_block<false>(lds, q, KCAT, k, 512, vt, 256, 8, 7, nullptr, q, KCAT, tid, lane);
}
__device__ __forceinline__ void dsa_block(unsigned char* ws, LAS unsigned char* lds, int u, int tid, int wave, int lane) {
    const int qb = u & 7, h = (u >> 3) & 7, b = u >> 6;
    const int qt = qb * 8 + wave;
    bf16* q = (bf16*)(ws + WS_CAT1) + (size_t)(b * SEQ + qt * 32) * KCAT + h * 128;
    const bf16* k = (const bf16*)(ws + WS_KB) + (size_t)(b * SEQ) * 1024 + h * 128;
    const bf16* vt = (const bf16*)(ws + WS_VT) + ((size_t)b * 8 + h) * 128 * 2048;
    const unsigned* mk = (const unsigned*)(ws + WS_MASK) + (size_t)(b * SEQ + qt * 32) * 64;
    attn_block<true>(lds, q, KCAT, k, 1024, vt, 2048, qb * 8 + 8, qt, mk, q, KCAT, tid, lane);
}

__device__ __forceinline__ unsigned mono_key(float s) { unsigned b = __builtin_bit_cast(unsigned, s); if ((b << 1) == 0u) b = 0u; return (b & 0x80000000u) ? ~b : (b | 0x80000000u); }
__device__ __forceinline__ int half_sum(int v) {
#pragma unroll
    for (int o = 1; o < 32; o <<= 1) v += __shfl_xor(v, o);
    return v;
}
template <int JJ>
__device__ __forceinline__ void topk_pass(unsigned char* ws, LAS unsigned* SC, const bf16x8 (&af)[4], int b, int t0, int ntile, int lane) {
    const int c = lane & 31, hi = lane >> 5;
    const bf16* IK = (const bf16*)(ws + WS_IK); const float* IW = (const float*)(ws + WS_IW);
    unsigned* MASK = (unsigned*)(ws + WS_MASK);
    const int tq = t0 + 2 * hi + JJ;
    float w[8];
    { const float* wp = IW + (size_t)(b * SEQ + tq) * 8;
#pragma unroll
      for (int h = 0; h < 8; ++h) w[h] = wp[h] * 0.125f; }
    LAS unsigned* sc = SC + hi * 2048 + c;
#pragma unroll 1
    for (int kt0 = 0; kt0 < 64; kt0 += 4) {
        if (kt0 < ntile) {
            bf16x8 bfr[4][4];
#pragma unroll
            for (int q = 0; q < 4; ++q) { const bf16* bp = IK + (size_t)(b * SEQ + (kt0 + q) * 32 + c) * 64 + 8 * hi;
#pragma unroll
                for (int s = 0; s < 4; ++s) bfr[q][s] = *(const bf16x8*)(bp + 16 * s); }
#pragma unroll
            for (int q = 0; q < 4; ++q) { const int key = (kt0 + q) * 32 + c;
                f32x16 acc;
#pragma unroll
                for (int r = 0; r < 16; ++r) acc[r] = 0.f;
#pragma unroll
                for (int s = 0; s < 4; ++s) acc = __builtin_amdgcn_mfma_f32_32x32x16_bf16(af[s], bfr[q][s], acc, 0, 0, 0);
                float s_ = 0.f;
#pragma unroll
                for (int h = 0; h < 8; ++h) s_ += w[h] * fmaxf(acc[8 * JJ + h], 0.f);
                sc[(kt0 + q) * 32] = (key <= tq) ? mono_key(s_) : 0u; }
        } else {
#pragma unroll
            for (int q = 0; q < 4; ++q) sc[(kt0 + q) * 32] = 0u;
        }
    }
    LDS_WAIT(); asm volatile("" ::: "memory");
    unsigned U[64];
#pragma unroll
    for (int kt = 0; kt < 64; ++kt) U[kt] = sc[kt * 32];
    const bool all_valid = (tq + 1 <= 256);
    bool done = all_valid; unsigned T = all_valid ? 1u : 0u;
#pragma unroll 1
    for (int bit = 31; bit >= 0; --bit) {
        if (__all(done)) break;
        const unsigned cand = T | (1u << bit); int cl = 0, ch = 0;
#pragma unroll
        for (int kt = 0; kt < 64; ++kt) { const unsigned long long mk = __ballot(U[kt] >= cand); cl += __popc((unsigned)mk); ch += __popc((unsigned)(mk >> 32)); }
        const int cnt = hi ? ch : cl;
        if (!done) { if (cnt >= 256) T = cand; if (cnt == 256) done = true; }
    }
    int gl = 0, gh = 0;
#pragma unroll
    for (int kt = 0; kt < 64; ++kt) { const unsigned long long mk = __ballot(U[kt] > T); gl += __popc((unsigned)mk); gh += __popc((unsigned)(mk >> 32)); }
    const int ngt = hi ? gh : gl;
    const int need = all_valid ? 0x7fffffff : 256 - ngt;
    int eqc = 0; const unsigned lt = (1u << c) - 1u;
#pragma unroll 1
    for (int kt = 0; kt < ntile; ++kt) {
        const unsigned uk = sc[kt * 32];
        const bool eq = uk == T, gt = uk > T;
        const unsigned long long bal = __ballot(eq); const unsigned hb = hi ? (unsigned)(bal >> 32) : (unsigned)bal;
        const int rank = __popc(hb & lt);
        const bool sel = gt || (eq && (eqc + rank < need));
        eqc += __popc(hb);
        const unsigned long long wb = __ballot(sel);
        if (lane == 0) MASK[(size_t)(b * SEQ + t0 + JJ) * 64 + kt] = (unsigned)wb;
        if (lane == 32) MASK[(size_t)(b * SEQ + t0 + 2 + JJ) * 64 + kt] = (unsigned)(wb >> 32);
    }
    LDS_WAIT(); asm volatile("" ::: "memory");
}
__device__ __forceinline__ void topk_unit(unsigned char* ws, LAS unsigned char* lds, int wave, int u, int lane) {
    const int b = u >> 9, t0 = (u & 511) * 4;
    const int c = lane & 31, hi = lane >> 5;
    const bf16* IQ = (const bf16*)(ws + WS_IQ);
    LAS unsigned* SC = (LAS unsigned*)(lds + wave * 16384);
    bf16x8 af[4];
    { const int i = c, qi = t0 + 2 * ((i >> 2) & 1) + ((i >> 4) & 1), hd = (i & 3) | (((i >> 3) & 1) << 2);
      const bf16* ap = IQ + (size_t)(b * SEQ + qi) * 512 + hd * 64 + 8 * hi;
#pragma unroll
      for (int s = 0; s < 4; ++s) af[s] = *(const bf16x8*)(ap + 16 * s); }
    const int ntile = (t0 + 3) / 32 + 1;
    topk_pass<0>(ws, SC, af, b, t0, ntile, lane);
    topk_pass<1>(ws, SC, af, b, t0, ntile, lane);
}
__device__ __forceinline__ void lru_item(const Ptrs& P, LAS unsigned char* lds, int b, int n, int half, int tid, int wave, int lane) {
    unsigned char* ws = P.ws;
    const bf16* XBR = (const bf16*)(ws + WS_XBR); const bf16* GBR = (const bf16*)(ws + WS_GBR); bf16* CAT = (bf16*)(ws + WS_CAT0);
    LAS bf16* WAt = (LAS bf16*)lds;
    LAS bf16* WXt = (LAS bf16*)(lds + 4608);
    LAS float* SUM = (LAS float*)(lds + 9216);
    LAS float* XC = (LAS float*)(lds + 16384 + wave * 8320);
    for (int e = tid; e < 2048; e += 512) { const int in = e >> 5, out = e & 31;
        WAt[out * 72 + in] = (bf16)pg8::bf1(P.lru_w_a[((size_t)n * 64 + in) * 64 + 32 * half + out]);
        WXt[out * 72 + in] = (bf16)pg8::bf1(P.lru_w_x[((size_t)n * 64 + in) * 64 + 32 * half + out]); }
    __syncthreads();
    const int c = lane & 31, hi = lane >> 5;
    const int ch = n * 64 + 32 * half + c;
    const float ba = P.lru_b_a[ch], bx = P.lru_b_x[ch], sp = log1pf(__expf(-P.lru_lambda[ch]));
    const int chl = n * 64 + lane;
    const float cw0 = P.lru_conv_w[chl], cw1 = P.lru_conv_w[1024 + chl], cw2 = P.lru_conv_w[2048 + chl], cw3 = P.lru_conv_w[3072 + chl], cb = P.lru_conv_b[chl];
    float R = 0.f;
    for (int round = 0; round < 8; ++round) {
        const int tb = round * 256 + wave * 32;
        const size_t rowb = (size_t)b * SEQ + tb;
        bf16 xr[35], gr[16];
        { const bf16* xp = XBR + rowb * 1024 + chl;
#pragma unroll
          for (int tt = 0; tt < 35; ++tt) xr[tt] = (tt >= 3 || tb > 0) ? xp[(tt - 3) * 1024] : (bf16)0;
          const bf16* gp = GBR + rowb * 1024 + ch;
#pragma unroll
          for (int r = 0; r < 16; ++r) gr[r] = gp[((r & 3) + 8 * (r >> 2) + 4 * hi) * 1024]; }
#pragma unroll
        for (int tt = 0; tt < 32; ++tt)
            XC[tt * 65 + lane] = cb + cw0 * bf2f(xr[tt]) + cw1 * bf2f(xr[tt + 1]) + cw2 * bf2f(xr[tt + 2]) + cw3 * bf2f(xr[tt + 3]);
        LDS_WAIT(); asm volatile("" ::: "memory");
        f32x16 accA, accX;
#pragma unroll
        for (int r = 0; r < 16; ++r) { accA[r] = 0.f; accX[r] = 0.f; }
#pragma unroll
        for (int s = 0; s < 4; ++s) { float t8[8];
#pragma unroll
            for (int j = 0; j < 8; ++j) t8[j] = XC[c * 65 + 16 * s + 8 * hi + j];
            const bf16x8 af = pack8(t8);
            const bf16x8 wa = *(const LAS bf16x8*)(WAt + c * 72 + 16 * s + 8 * hi), wx = *(const LAS bf16x8*)(WXt + c * 72 + 16 * s + 8 * hi);
            accA = __builtin_amdgcn_mfma_f32_32x32x16_bf16(af, wa, accA, 0, 0, 0); accX = __builtin_amdgcn_mfma_f32_32x32x16_bf16(af, wx, accX, 0, 0, 0); }
        float hloc[16], pl[16], gg[16];
        const int par = round & 1;
        {
            float Ag[4], Hg[4];
#pragma unroll
            for (int g = 0; g < 4; ++g) { float h = 0.f, p = 1.f;
#pragma unroll
                for (int j = 0; j < 4; ++j) { const int r = 4 * g + j, tok = j + 8 * g + 4 * hi;
                    const float xc = XC[tok * 65 + 32 * half + c];
                    const float gb = bf2f(gr[r]);
                    const float rg = sigmoidf_(accA[r] + ba), ig = sigmoidf_(accX[r] + bx);
                    const float la = -8.0f * rg * sp, a = __expf(la), z = 2.0f * la;
                    const float em = (z > -0.05f) ? -z * (1.0f + z * (0.5f + z * (0.16666667f + z * 0.041666667f))) : 1.0f - __expf(z);
                    const float bt = sqrtf(em) * (ig * xc);
                    h = a * h + bt; p = p * a; hloc[r] = h; pl[r] = p;
                    const float u2 = 1.5957691216057308f * (gb + 0.044715f * gb * gb * gb);
                    gg[r] = gb * sigmoidf_(u2); }
                Ag[g] = p; Hg[g] = h; }
            float cc = 0.f, qq = 1.f;
#pragma unroll
            for (int g = 0; g < 4; ++g) { const float Ap = __shfl_xor(Ag[g], 32), Hp = __shfl_xor(Hg[g], 32);
                const float fA = hi ? Ap : Ag[g], fH = hi ? Hp : Hg[g], sA = hi ? Ag[g] : Ap, sH = hi ? Hg[g] : Hp;
                const float c1 = fA * cc + fH, q1 = qq * fA;
                const float hin = hi ? c1 : cc, pin = hi ? q1 : qq;
                cc = sA * c1 + sH; qq = q1 * sA;
#pragma unroll
                for (int j = 0; j < 4; ++j) { const int r = 4 * g + j; hloc[r] = hloc[r] + pl[r] * hin; pl[r] = pl[r] * pin; } }
            if (hi == 0) { LAS float* sp2 = SUM + ((par * 8 + wave) * 32 + c) * 2; sp2[0] = cc; sp2[1] = qq; }
        }
        LDS_WAIT(); __syncthreads();
        {
            float Rw = R, hin = 0.f;
#pragma unroll
            for (int w2 = 0; w2 < 8; ++w2) { const LAS float* sp2 = SUM + ((par * 8 + w2) * 32 + c) * 2; const float C = sp2[0], Q = sp2[1];
                if (w2 == wave) hin = Rw; Rw = Q * Rw + C; }
            R = Rw;
#pragma unroll
            for (int r = 0; r < 16; ++r) { const int tok = (r & 3) + 8 * (r >> 2) + 4 * hi;
                const float y = (hloc[r] + pl[r] * hin) * gg[r];
                CAT[(rowb + tok) * KCAT + ch] = (bf16)pg8::bf1(y); }
        }
    }
    __syncthreads();
}

__device__ __forceinline__ void ffn_fixup_item(const Ptrs& P, int l, int chunk, int tid) {
    unsigned char* ws = P.ws;
    const float* HALO = (const float*)(ws + WS_HALO); bf16* ACT = (bf16*)(ws + WS_ACT);
    const float* cw = P.ffn_conv_w + (size_t)l * 3 * NUP; const float* cb = P.ffn_conv_b + (size_t)l * NUP;
    const bool first = (chunk % 32) == 0;
    const size_t r0 = (size_t)chunk * 64;
    for (int ch = tid; ch < DFF; ch += 512) {
        float y[2][2];
#pragma unroll
        for (int hf = 0; hf < 2; ++hf) {
            const float* hc = HALO + ((size_t)(chunk * 4) * 2 + hf) * DFF + ch;
            const float u0 = hc[0], u1 = hc[2 * DFF];
            float um2 = 0.f, um1 = 0.f;
            if (!first) { const float* hpv = HALO + ((size_t)((chunk - 1) * 4) * 2 + hf) * DFF + ch; um2 = hpv[2 * 2 * DFF]; um1 = hpv[3 * 2 * DFF]; }
            const int cc = hf * DFF + ch;
            const float w0 = cw[cc], w1 = cw[NUP + cc], w2 = cw[2 * NUP + cc], bb = cb[cc];
            y[hf][0] = bb + w0 * um2 + w1 * um1 + w2 * u0;
            y[hf][1] = bb + w0 * um1 + w1 * u0 + w2 * u1;
        }
#pragma unroll
        for (int k = 0; k < 2; ++k) { const float yg = y[0][k]; ACT[(r0 + k) * DFF + ch] = (bf16)pg8::bf1(yg * __builtin_amdgcn_rcpf(1.0f + __expf(-yg)) * y[1][k]); }
    }
}

__device__ __forceinline__ void final_norm_rows(const Ptrs& P, int gw, int NGW, int lane) {
    const float* ssp = (const float*)(P.ws + WS_SSP);
    for (int m = gw; m < M; m += NGW) {
        const float rs = pg8::rstd4(ssp, m);
        f32x4* xr = (f32x4*)(P.out + (size_t)m * DM) + lane; const f32x4* gr = (const f32x4*)P.final_norm + lane;
#pragma unroll
        for (int j = 0; j < 4; ++j) { const f32x4 v = xr[64 * j], g = gr[64 * j]; xr[64 * j] = v * rs * g; }
    }
}
struct Args { const void* in[23]; float* out; unsigned char* ws; int ph_lo, ph_hi; };
__global__ void __launch_bounds__(NWAVES * 64, 2) trunk_fwd(Args args) {
    extern __shared__ __attribute__((aligned(16))) unsigned char lds_raw[];
    LAS unsigned char* lds = (LAS unsigned char*)lds_raw;
    const int tid = threadIdx.x, lane = tid & 63, wave = __builtin_amdgcn_readfirstlane(tid >> 6);
    const int G = gridDim.x, bx = blockIdx.x;
    const int vcu = (G % 8 == 0) ? (bx % 8) * (G / 8) + bx / 8 : bx;
    const int gw = vcu * NWAVES + wave, NGW = G * NWAVES;
    Ptrs P;
    P.x = (const float*)args.in[0]; P.mem = (const float*)args.in[1]; P.pos = (const int*)args.in[2]; P.norm_mix = (const float*)args.in[3]; P.norm_ffn = (const float*)args.in[4];
    P.mem_norm = (const float*)args.in[5]; P.final_norm = (const float*)args.in[6]; P.w_mem_kv = (const float*)args.in[7]; P.w_ffn_up = (const float*)args.in[8];
    P.ffn_conv_w = (const float*)args.in[9]; P.ffn_conv_b = (const float*)args.in[10]; P.w_ffn_down = (const float*)args.in[11]; P.lru_w_in = (const float*)args.in[12];
    P.lru_conv_w = (const float*)args.in[13]; P.lru_conv_b = (const float*)args.in[14]; P.lru_w_a = (const float*)args.in[15]; P.lru_b_a = (const float*)args.in[16];
    P.lru_w_x = (const float*)args.in[17]; P.lru_b_x = (const float*)args.in[18]; P.lru_lambda = (const float*)args.in[19]; P.lru_w_out = (const float*)args.in[20];
    P.dsa_w_in = (const float*)args.in[21]; P.dsa_w_out = (const float*)args.in[22]; P.out = args.out; P.ws = args.ws;
    unsigned char* ws = args.ws;
    for (int u = tid; u < (LDS_BYTES - LDSCTL_OFF) / 4; u += NWAVES * 64) ((LAS unsigned*)(lds + LDSCTL_OFF))[u] = 0u;
    __syncthreads();
    const int lo = args.ph_lo, hi = args.ph_hi;
    XcdBarrier bar; bar.bar = (unsigned*)(ws + WS_CTL) + CW_BAR; bar.x = 0; bar.st = nullptr;
    if (hi - lo > 1) bar = xcd_barrier_post((unsigned*)(ws + WS_CTL) + CW_BAR, (volatile LAS unsigned*)(lds + MISC_OFF) + 8);
#ifndef PH_MASK
#define PH_MASK 0x7fff
#endif
#define IN(k) ((((PH_MASK) >> (k)) & 1) && lo <= (k) && (k) < hi)
#ifdef PROBE_PHASE
    unsigned long long pr_last = __builtin_amdgcn_s_memrealtime(), pr_dt = 0;
#define SEAM(k) do { if (IN(k) && IN((k) + 1)) xcd_barrier(bar); { const unsigned long long now_ = __builtin_amdgcn_s_memrealtime(); if ((k) == PROBE_PHASE) pr_dt = now_ - pr_last; pr_last = now_; } } while (0)
#else
#define SEAM(k) do { if (IN(k) && IN((k) + 1)) xcd_barrier(bar); } while (0)
#endif
    float* ssp = (float*)(ws + WS_SSP);
    bf16* xb16 = (bf16*)(ws + WS_XB16);

    if (IN(0)) { int ln = lane; asm volatile("" : "+v"(ln)); p0_prologue(P, lds, gw, NGW, wave, ln); }
    SEAM(0);
    if (IN(1)) {
        { pg8::Gemm g{(const bf16*)(ws + WS_MEM16), (const bf16*)(ws + WS_WKV), MMEM, 2048, DM}; pg8::StaticOrder S; S.init(MMEM, 2048, G, (bx + G / 2) % G);
          pg8::EpiKV E{(const float*)(ws + WS_SSM), (bf16*)(ws + WS_MK), (bf16*)(ws + WS_MVT)};
          pg8::gemm_phase<pg8::EpiKV, pg8::StaticOrder, true, true>(lds + RING_OFF, g, S, E); }
        { pg8::Gemm g{xb16, (const bf16*)(ws + WS_WIN0), M, NIN0, DM}; pg8::StaticOrder S; S.init(M, NIN0, G, bx);
          pg8::EpiIn0 E{ssp, (bf16*)(ws + WS_XBR), (bf16*)(ws + WS_GBR), (bf16*)(ws + WS_CAT0)};
          pg8::gemm_phase<pg8::EpiIn0, pg8::StaticOrder, true, true>(lds + RING_OFF, g, S, E); }
    }
    SEAM(1);
    if (IN(2)) {
        int ln = lane, td = tid; asm volatile("" : "+v"(ln), "+v"(td));
        lru_item(P, lds, vcu >> 5, (vcu >> 1) & 15, vcu & 1, td, wave, ln);
        for (int u = vcu; u < 256; u += G) memattn_block(ws, lds, 0, (bf16*)(ws + WS_CAT0), u, td, wave, ln);
    }
    SEAM(2);
    if (IN(3)) { pg8::Gemm g{(const bf16*)(ws + WS_CAT0), (const bf16*)(ws + WS_WOUT0), M, DM, KCAT}; pg8::StaticOrder S; S.init(M, DM, G, bx);
        pg8::EpiOut E{P.x, P.out, xb16, ssp};
        pg8::gemm_phase<pg8::EpiOut, pg8::StaticOrder, false, true>(lds + RING_OFF, g, S, E); }
    SEAM(3);
    for (int l = 0; l < 2; ++l) {
        const int pb = l ? 11 : 4;
        if (l == 1) {
            if (IN(7)) { pg8::Gemm g{xb16, (const bf16*)(ws + WS_WIN1), M, NIN1, DM}; pg8::StaticOrder S; S.init(M, NIN1, G, bx);
                pg8::EpiIn1 E{ssp, (const float*)(ws + WS_COSA), (const float*)(ws + WS_SINA), (const float*)(ws + WS_COSI), (const float*)(ws + WS_SINI),
                              (bf16*)(ws + WS_CAT1), (bf16*)(ws + WS_KB), (bf16*)(ws + WS_VT), (bf16*)(ws + WS_IQ), (bf16*)(ws + WS_IK), (float*)(ws + WS_IW)};
                pg8::gemm_phase<pg8::EpiIn1, pg8::StaticOrder, true, true>(lds + RING_OFF, g, S, E); }
            SEAM(7);
            if (IN(8)) { int ln = lane; asm volatile("" : "+v"(ln)); for (int u = gw; u < 2048; u += NGW) { topk_unit(ws, lds, wave, u, ln); topk_unit(ws, lds, wave, 4095 - u, ln); } }
            SEAM(8);
            if (IN(9)) { int ln = lane, td = tid; asm volatile("" : "+v"(ln), "+v"(td));
                for (int u = vcu; u < 256; u += G) { dsa_block(ws, lds, u, td, wave, ln); dsa_block(ws, lds, 511 - u, td, wave, ln); memattn_block(ws, lds, 1, (bf16*)(ws + WS_CAT1), u, td, wave, ln); } }
            SEAM(9);
            if (IN(10)) { pg8::Gemm g{(const bf16*)(ws + WS_CAT1), (const bf16*)(ws + WS_WOUT1), M, DM, KCAT}; pg8::StaticOrder S; S.init(M, DM, G, bx);
                pg8::EpiOut E{P.out, P.out, xb16, ssp};
                pg8::gemm_phase<pg8::EpiOut, pg8::StaticOrder, false, true>(lds + RING_OFF, g, S, E); }
            SEAM(10);
        }
        if (IN(pb)) { pg8::Gemm g{xb16, (const bf16*)(ws + (l ? WS_WUP1 : WS_WUP0)), M, NUP, DM}; pg8::StaticOrder S; S.init(M, NUP, G, bx);
            pg8::EpiUp E{ssp, P.ffn_conv_w + (size_t)l * 3 * NUP, P.ffn_conv_b + (size_t)l * NUP, (bf16*)(ws + WS_ACT), (float*)(ws + WS_HALO)};
            pg8::gemm_phase<pg8::EpiUp, pg8::StaticOrder, true, true>(lds + RING_OFF, g, S, E); }
        SEAM(pb);
        if (IN(pb + 1)) { int td = tid; asm volatile("" : "+v"(td)); for (int ck = bx; ck < 256; ck += G) ffn_fixup_item(P, l, ck, td); }
        SEAM(pb + 1);
        if (IN(pb + 2)) { pg8::Gemm g{(const bf16*)(ws + WS_ACT), (const bf16*)(ws + (l ? WS_WDN1 : WS_WDN0)), M, DM, DFF}; pg8::StaticOrder S; S.init(M, DM, G, bx);
            pg8::EpiOut E{P.out, P.out, xb16, ssp};
            pg8::gemm_phase<pg8::EpiOut, pg8::StaticOrder, false, true>(lds + RING_OFF, g, S, E); }
        SEAM(pb + 2);
    }
    if (IN(14)) { int ln = lane; asm volatile("" : "+v"(ln)); final_norm_rows(P, gw, NGW, ln); }
#ifdef PROBE_PHASE
    { const unsigned long long now_ = __builtin_amdgcn_s_memrealtime(); if (14 == PROBE_PHASE) pr_dt = now_ - pr_last;
      if (bx == 0 && wave == 0) { const unsigned long long tgt = now_ + PROBE_AMP * pr_dt; while (__builtin_amdgcn_s_memrealtime() < tgt) __builtin_amdgcn_s_sleep(32); } }
#endif
#undef IN
#undef SEAM
}

extern "C" void kernel_launch(void* const* d_in, const int* in_sizes, int n_in, void* d_out, int out_size, void* d_ws, size_t ws_size, hipStream_t stream) {
    static int grid = 0;
    if (grid == 0) {
        if (n_in != 23 || out_size != M * DM || ws_size < WS_END) { fprintf(stderr, "kernel_launch: unexpected problem shape (n_in %d out %d ws %zu)\n", n_in, out_size, ws_size); grid = -1; return; }
        int dev = 0, cus = 0;
        if (hipGetDevice(&dev) != hipSuccess || hipDeviceGetAttribute(&cus, hipDeviceAttributeMultiprocessorCount, dev) != hipSuccess) { grid = -1; return; }
        if (hipFuncSetAttribute((const void*)trunk_fwd, hipFuncAttributeMaxDynamicSharedMemorySize, LDS_BYTES) != hipSuccess) { fprintf(stderr, "kernel_launch: hipFuncSetAttribute failed\n"); grid = -1; return; }
        int per_cu = 0;
        if (hipOccupancyMaxActiveBlocksPerMultiprocessor(&per_cu, (const void*)trunk_fwd, NWAVES * 64, LDS_BYTES) != hipSuccess || per_cu < 1) fprintf(stderr, "kernel_launch: occupancy query says %d\n", per_cu);
        (void)hipGetLastError();
        grid = cus;
        if (grid != 256) { fprintf(stderr, "kernel_launch: built for 256 CUs, found %d\n", grid); grid = -1; return; }
    }
    if (grid < 0) return;
    if (hipMemsetAsync((char*)d_ws + WS_CTL, 0, CTL_ZERO_BYTES, stream) != hipSuccess) return;
    Args a{};
    for (int i = 0; i < 23; ++i) a.in[i] = d_in[i];
    a.out = (float*)d_out; a.ws = (unsigned char*)d_ws;
#if MK_N_LAUNCHES == 1
    a.ph_lo = 0; a.ph_hi = N_PHASES;
    hipLaunchKernelGGL(trunk_fwd, dim3(grid), dim3(NWAVES * 64), LDS_BYTES, stream, a);
#else
    for (int p = 0; p < N_PHASES; ++p) { a.ph_lo = p; a.ph_hi = p + 1; hipLaunchKernelGGL(trunk_fwd, dim3(grid), dim3(NWAVES * 64), LDS_BYTES, stream, a); }
#endif
}
```

```cpp
#include <hip/hip_runtime.h>
#include <cstdio>
#include <cstdint>
namespace pg8 {
#define PG8_LAS __attribute__((address_space(3)))
typedef unsigned short bf16_t;
typedef short bf16x8 __attribute__((ext_vector_type(8)));
typedef float f32x4 __attribute__((ext_vector_type(4)));
typedef unsigned u32x4 __attribute__((ext_vector_type(4)));
constexpr int BM = 256, BK = 64, HALF = 128, HTB = HALF * BK * 2  , STAGE_BYTES = 8 * HTB, NXCD = 8, WGM = 8;

__host__ __device__ __forceinline__ int lds_byte(int r, int c) { const int st = (r >> 4) * 2 + (c >> 5), rr = r & 15, cc = c & 31, ob = rr * 64 + cc * 2; return st * 1024 + (ob ^ (((ob >> 9) & 1) << 5)); }
__host__ __device__ __forceinline__ void stage_rc(int b, int& R, int& C) { const int st = b / 1024, sb = b % 1024, swz = sb ^ (((sb >> 9) & 1) << 5); R = (st >> 1) * 16 + swz / 64; C = (st & 1) * 32 + (swz % 64) / 2; }
__host__ __device__ __forceinline__ int perm32(int rho) { const int n = rho >> 4, i = rho & 15; return 8 * (i >> 2) + 4 * n + (i & 3); }

struct Unit { int pm, pn; };
struct Gemm { const bf16_t* A; const bf16_t* Bt; int M, N, K; };

struct StaticOrder {
    int nM, nN, nwg, G, c;
    __host__ __device__ void init(int M, int N, int G_, int c_) { nM = M / BM; nN = N / BM; nwg = nM * nN; G = G_; c = c_; }
    __host__ __device__ bool next(int i, Unit& u) const {
        const long L = (long)i * G + c; if (L >= nwg) return false;
        int wgid = (int)L; { const int q = nwg / NXCD, r = nwg % NXCD, xcd = wgid % NXCD, off = wgid / NXCD; wgid = (xcd < r ? xcd * (q + 1) : r * (q + 1) + (xcd - r) * q) + off; }
        const int nig = WGM * nN, gid = wgid / nig, fm = gid * WGM, gsz = (nM - fm) < WGM ? (nM - fm) : WGM;
        u.pm = fm + ((wgid % nig) % gsz); u.pn = (wgid % nig) / gsz; return true;
    }
    __device__ __forceinline__ void a_ready(const Unit&) const {}
    __device__ __forceinline__ void done(const Unit&) const {}
};

__device__ __forceinline__ unsigned cvt_pk_bf16(float lo, float hi) { unsigned r; asm volatile("v_cvt_pk_bf16_f32 %0, %1, %2" : "=v"(r) : "v"(lo), "v"(hi)); return r; }

template <class Epi, class Sched, bool ALIGN_EPI = false, bool SP2 = false>
__device__ __forceinline__ void gemm_phase(PG8_LAS unsigned char* lds, const Gemm g, const Sched& S, const Epi& E) {
    int tid_ = threadIdx.x; asm volatile("" : "+v"(tid_));
    const int tid = tid_, wid = __builtin_amdgcn_readfirstlane(tid >> 6), lane = tid & 63, wr = wid >> 2, wc = wid & 3, fr = lane & 15, fq = lane >> 4;
    const int K = g.K, nt = K / BK;
    unsigned voffA[2], voffB[2];
#pragma unroll
    for (int i = 0; i < 2; ++i) { int R, C; stage_rc(tid * 16 + i * 8192, R, C); const int Rb = Epi::PERM ? ((R & ~31) + perm32(R & 31)) : R;
        voffA[i] = (unsigned)(R * K + C) * 2u; voffB[i] = (unsigned)(Rb * K + C) * 2u; }
    const size_t kstep = (size_t)(BK * 2);
    const size_t hstep = (size_t)HALF * K * 2;
    const size_t tstep = 2 * hstep;
    const unsigned ldsw = (unsigned)wid * 1024u;
    const int aoff = lds_byte(wr * 64 + fr, fq * 8), boff = lds_byte(wc * 32 + fr, fq * 8);
#define PG8_SA(b, h) (((b) * 2 + (h)) * HTB)
#define PG8_SB(b, h) ((4 + (b) * 2 + (h)) * HTB)
#define PG8_STAGE(bufoff, gbase, voff) do { _Pragma("unroll") for (int _i = 0; _i < 2; ++_i) \
        __builtin_amdgcn_global_load_lds((const unsigned*)((const char*)(gbase) + (voff)[_i]), (PG8_LAS unsigned*)(lds + (bufoff) + ldsw + _i * 8192), 16, 0, 0); } while (0)
#define PG8_LDA(dst, b, h) do { _Pragma("unroll") for (int m = 0; m < 4; ++m) _Pragma("unroll") for (int k = 0; k < 2; ++k) dst[m][k] = *(const PG8_LAS bf16x8*)(lds + PG8_SA(b, h) + aoff + m * 2048 + k * 1024); } while (0)
#define PG8_LDB(dst, b, h) do { _Pragma("unroll") for (int n = 0; n < 2; ++n) _Pragma("unroll") for (int k = 0; k < 2; ++k) dst[n][k] = *(const PG8_LAS bf16x8*)(lds + PG8_SB(b, h) + boff + n * 2048 + k * 1024); } while (0)
#define PG8_MMA(ai, bj, At, Bt) do { __builtin_amdgcn_s_setprio(1); _Pragma("unroll") for (int m = 0; m < 4; ++m) _Pragma("unroll") for (int n = 0; n < 2; ++n) _Pragma("unroll") for (int k = 0; k < 2; ++k) \
        acc[ai][bj][m][n] = __builtin_amdgcn_mfma_f32_16x16x32_bf16(Bt[n][k], At[m][k], acc[ai][bj][m][n], 0, 0, 0); __builtin_amdgcn_s_setprio(0); } while (0)
#define PG8_WAIT_V(n) asm volatile("s_waitcnt vmcnt(" #n ")" ::: "memory")
#define PG8_WAIT_L(n) asm volatile("s_waitcnt lgkmcnt(" #n ")" ::: "memory")
#define PG8_BAR __builtin_amdgcn_s_barrier()
#define PG8_SCHED __builtin_amdgcn_sched_barrier(0)
    Unit cur, nxt; int ui = 0;
    if (!S.next(0, cur)) return;
    f32x4 acc[2][2][4][2];
#pragma unroll
    for (int a = 0; a < 2; ++a)
#pragma unroll
        for (int b = 0; b < 2; ++b)
#pragma unroll
            for (int m = 0; m < 4; ++m)
#pragma unroll
                for (int n = 0; n < 2; ++n) acc[a][b][m][n] = (f32x4){0.f, 0.f, 0.f, 0.f};
    bf16x8 At[4][2], B0[2][2], B1[2][2];
    const char* cA = (const char*)g.A + (size_t)cur.pm * tstep; const char* cB = (const char*)g.Bt + (size_t)cur.pn * tstep;
    S.a_ready(cur);
    if constexpr (SP2) {
        PG8_STAGE(PG8_SB(0, 0), cB, voffB); PG8_STAGE(PG8_SB(0, 1), cB + hstep, voffB); PG8_STAGE(PG8_SA(0, 0), cA, voffA); PG8_STAGE(PG8_SA(0, 1), cA + hstep, voffA);
        if (wr == 1) PG8_BAR;
        PG8_WAIT_V(2); PG8_BAR;
        PG8_STAGE(PG8_SB(1, 0), cB + kstep, voffB); PG8_STAGE(PG8_SA(1, 0), cA + kstep, voffA); PG8_STAGE(PG8_SB(1, 1), cB + hstep + kstep, voffB);
        PG8_WAIT_V(6); PG8_BAR;
    } else {
        PG8_STAGE(PG8_SB(0, 0), cB, voffB); PG8_STAGE(PG8_SA(0, 0), cA, voffA); PG8_STAGE(PG8_SB(0, 1), cB + hstep, voffB); PG8_STAGE(PG8_SA(0, 1), cA + hstep, voffA);
        if (wr == 1) PG8_BAR;
        PG8_WAIT_V(4); PG8_BAR;
        PG8_STAGE(PG8_SB(1, 0), cB + kstep, voffB); PG8_STAGE(PG8_SA(1, 0), cA + kstep, voffA); PG8_STAGE(PG8_SB(1, 1), cB + hstep + kstep, voffB);
        PG8_WAIT_V(6); PG8_BAR;
    }
    for (;;) {
        const bool has_next = S.next(ui + 1, nxt);
        const char* nA = has_next ? (const char*)g.A + (size_t)nxt.pm * tstep : cA; const char* nB = has_next ? (const char*)g.Bt + (size_t)nxt.pn * tstep : cB;
        for (int t = 0; t < nt; t += 2) {
            const bool last = (t == nt - 2);
            const char* a1 = cA + (size_t)(t + 1) * kstep;
            const char* a2 = last ? nA : cA + (size_t)(t + 2) * kstep; const char* b2 = last ? nB : cB + (size_t)(t + 2) * kstep;
            const char* a3 = a2 + kstep; const char* b3 = b2 + kstep;
            if (last && has_next) S.a_ready(nxt);
            if constexpr (SP2) {
            PG8_LDB(B0, 0, 0); PG8_LDB(B1, 0, 1); PG8_SCHED; PG8_LDA(At, 0, 0); PG8_STAGE(PG8_SA(1, 1), a1 + hstep, voffA);
            PG8_WAIT_V(8); PG8_WAIT_L(0); PG8_BAR; PG8_MMA(0, 0, At, B0); PG8_MMA(0, 1, At, B1); PG8_BAR; PG8_SCHED;
            PG8_LDA(At, 0, 1); PG8_STAGE(PG8_SB(0, 0), b2, voffB); PG8_STAGE(PG8_SB(0, 1), b2 + hstep, voffB); PG8_STAGE(PG8_SA(0, 0), a2, voffA);
            PG8_WAIT_V(8); PG8_WAIT_L(0); PG8_BAR; PG8_MMA(1, 0, At, B0); PG8_MMA(1, 1, At, B1); PG8_BAR; PG8_SCHED;
            PG8_LDB(B0, 1, 0); PG8_LDB(B1, 1, 1); PG8_SCHED; PG8_LDA(At, 1, 0); PG8_STAGE(PG8_SA(0, 1), a2 + hstep, voffA);
            PG8_WAIT_V(8); PG8_WAIT_L(0); PG8_BAR; PG8_MMA(0, 0, At, B0); PG8_MMA(0, 1, At, B1); PG8_BAR; PG8_SCHED;
            PG8_LDA(At, 1, 1); PG8_STAGE(PG8_SB(1, 0), b3, voffB); PG8_STAGE(PG8_SB(1, 1), b3 + hstep, voffB); PG8_STAGE(PG8_SA(1, 0), a3, voffA);
            PG8_WAIT_V(8); PG8_WAIT_L(0); PG8_BAR; PG8_MMA(1, 0, At, B0); PG8_MMA(1, 1, At, B1); PG8_BAR; PG8_SCHED;
            } else {
            PG8_LDB(B0, 0, 0); PG8_SCHED; PG8_LDA(At, 0, 0); PG8_STAGE(PG8_SA(1, 1), a1 + hstep, voffA);
            PG8_WAIT_L(8); PG8_BAR; PG8_WAIT_L(0); PG8_MMA(0, 0, At, B0); PG8_BAR; PG8_SCHED;
            PG8_LDB(B1, 0, 1); PG8_STAGE(PG8_SB(0, 0), b2, voffB);
            PG8_BAR; PG8_WAIT_L(0); PG8_MMA(0, 1, At, B1); PG8_BAR;
            PG8_LDA(At, 0, 1); PG8_STAGE(PG8_SA(0, 0), a2, voffA);
            PG8_BAR; PG8_WAIT_L(0); PG8_MMA(1, 0, At, B0); PG8_BAR; PG8_SCHED;
            PG8_STAGE(PG8_SB(0, 1), b2 + hstep, voffB);
            PG8_WAIT_V(6); PG8_BAR; PG8_MMA(1, 1, At, B1); PG8_BAR;
            PG8_LDB(B0, 1, 0); PG8_SCHED; PG8_LDA(At, 1, 0); PG8_STAGE(PG8_SA(0, 1), a2 + hstep, voffA);
            PG8_WAIT_L(8); PG8_BAR; PG8_WAIT_L(0); PG8_MMA(0, 0, At, B0); PG8_BAR; PG8_SCHED;
            PG8_LDB(B1, 1, 1); PG8_STAGE(PG8_SB(1, 0), b3, voffB);
            PG8_BAR; PG8_WAIT_L(0); PG8_MMA(0, 1, At, B1); PG8_BAR;
            PG8_LDA(At, 1, 1); PG8_STAGE(PG8_SA(1, 0), a3, voffA);
            PG8_BAR; PG8_WAIT_L(0); PG8_MMA(1, 0, At, B0); PG8_BAR; PG8_SCHED;
            PG8_STAGE(PG8_SB(1, 1), b3 + hstep, voffB);
            PG8_WAIT_V(6); PG8_BAR; PG8_MMA(1, 1, At, B1); PG8_BAR;
            }
        }
        if constexpr (ALIGN_EPI) { if (wr == 0) PG8_BAR; }
        if constexpr (!Epi::AFTER_DRAIN) { E(acc, cur, wr, wc, fr, fq); S.done(cur); }
        if (!has_next) break;
#pragma unroll
        for (int a = 0; a < 2; ++a)
#pragma unroll
            for (int b = 0; b < 2; ++b)
#pragma unroll
                for (int m = 0; m < 4; ++m)
#pragma unroll
                    for (int n = 0; n < 2; ++n) acc[a][b][m][n] = (f32x4){0.f, 0.f, 0.f, 0.f};
        cur = nxt; cA = nA; cB = nB; ++ui;
        if constexpr (ALIGN_EPI) { if (wr == 1) PG8_BAR; }
    }
    PG8_WAIT_V(0);
    if constexpr (!ALIGN_EPI) { if (wr == 0) PG8_BAR; }
    PG8_BAR;
    if constexpr (Epi::AFTER_DRAIN) { E.fused(acc, cur, wr, wc, fr, fq, lds, wid, lane); S.done(cur); }
#undef PG8_SA
#undef PG8_SB
#undef PG8_STAGE
#undef PG8_LDA
#undef PG8_LDB
#undef PG8_MMA
#undef PG8_WAIT_V
#undef PG8_WAIT_L
#undef PG8_BAR
#undef PG8_SCHED
}
}
namespace pg8 {
__device__ __forceinline__ unsigned bf1(float x) { return cvt_pk_bf16(x, x) & 0xffffu; }
constexpr float RMS_EPS = 1e-6f;
__device__ __forceinline__ float rstd4(const float* ssp, int row) {
    const f32x4 q = *(const f32x4*)(ssp + (unsigned)(row * 4));
    const float s = (q[0] + q[1]) + (q[2] + q[3]);
    return 1.0f / sqrtf(s * (1.0f / 1024.0f) + RMS_EPS);
}
template <int CTRL> __device__ __forceinline__ float dppf(float old, float src) {
    return __builtin_bit_cast(float, __builtin_amdgcn_update_dpp(__builtin_bit_cast(int, old), __builtin_bit_cast(int, src), CTRL, 0xf, 0xf, false));
}

struct EpiKV {
    static constexpr bool PERM = true, AFTER_DRAIN = false;
    const float* ssm;
    bf16_t* MK;
    bf16_t* MVT;
    __device__ __forceinline__ void operator()(const f32x4 (&acc)[2][2][4][2], const Unit& u, int wr, int wc, int fr_, int fq_) const {
        int fr = fr_, fq = fq_; asm volatile("" : "+v"(fr), "+v"(fq));
        const int l = u.pn >> 2, p4 = u.pn & 3;
        const int row0 = u.pm * BM + wr * 64 + fr, cl0 = wc * 32 + 8 * fq;
#pragma unroll
        for (int ai = 0; ai < 2; ++ai)
#pragma unroll
            for (int m = 0; m < 4; ++m) {
                const int row = row0 + ai * HALF + m * 16;
                const float rs = 1.0f / sqrtf(ssm[row] * (1.0f / 1024.0f) + RMS_EPS);
                if (p4 < 2) {
                    bf16_t* rowp = MK + ((size_t)l * 2048 + row) * 512 + p4 * 256 + cl0;
#pragma unroll
                    for (int bj = 0; bj < 2; ++bj) { const f32x4 v0 = acc[ai][bj][m][0] * rs, v1 = acc[ai][bj][m][1] * rs;
                        u32x4 w; w.x = cvt_pk_bf16(v0[0], v0[1]); w.y = cvt_pk_bf16(v0[2], v0[3]); w.z = cvt_pk_bf16(v1[0], v1[1]); w.w = cvt_pk_bf16(v1[2], v1[3]);
                        *(u32x4*)(rowp + bj * HALF) = w; }
                } else {
                    const int b = row >> 8, key = row & 255;
#pragma unroll
                    for (int bj = 0; bj < 2; ++bj)
#pragma unroll
                        for (int n = 0; n < 2; ++n)
#pragma unroll
                            for (int j = 0; j < 4; ++j) { const int c = (p4 - 2) * 256 + bj * HALF + cl0 + 4 * n + j, h = c >> 7, d = c & 127;
                                MVT[((((size_t)l * 8 + b) * 4 + h) * 128 + d) * 256 + key] = (bf16_t)bf1(acc[ai][bj][m][n][j] * rs); }
                }
            }
    }
};

struct EpiIn0 {
    static constexpr bool PERM = true, AFTER_DRAIN = false;
    const float* ssp; bf16_t *XBR, *GBR, *CAT;
    __device__ __forceinline__ void operator()(const f32x4 (&acc)[2][2][4][2], const Unit& u, int wr, int wc, int fr_, int fq_) const {
        int fr = fr_, fq = fq_; asm volatile("" : "+v"(fr), "+v"(fq));
        const int seg = u.pn >> 2; bf16_t* base; int pitch, colt;
        if (seg == 0) { base = XBR; pitch = 1024; colt = u.pn * 256; } else if (seg == 1) { base = GBR; pitch = 1024; colt = (u.pn - 4) * 256; } else { base = CAT + 1024; pitch = 1536; colt = (u.pn - 8) * 256; }
        const int row0 = u.pm * BM + wr * 64 + fr, col0 = colt + wc * 32 + 8 * fq;
#pragma unroll
        for (int ai = 0; ai < 2; ++ai)
#pragma unroll
            for (int m = 0; m < 4; ++m) { const int row = row0 + ai * HALF + m * 16; const float rs = rstd4(ssp, row);
                bf16_t* rowp = base + (size_t)row * pitch + col0;
#pragma unroll
                for (int bj = 0; bj < 2; ++bj) { const f32x4 v0 = acc[ai][bj][m][0] * rs, v1 = acc[ai][bj][m][1] * rs;
                    u32x4 w; w.x = cvt_pk_bf16(v0[0], v0[1]); w.y = cvt_pk_bf16(v0[2], v0[3]); w.z = cvt_pk_bf16(v1[0], v1[1]); w.w = cvt_pk_bf16(v1[2], v1[3]);
                    *(u32x4*)(rowp + bj * HALF) = w; } }
    }
};

struct EpiOut {
    static constexpr bool PERM = false, AFTER_DRAIN = true;
    const float* base; float* out; bf16_t* xb16; float* ssp;
    __device__ __forceinline__ void fused(f32x4 (&acc)[2][2][4][2], const Unit& u, int wr, int wc, int fr, int fq, PG8_LAS unsigned char* lds, int wid, int lane) const {
        typedef unsigned u32x2v __attribute__((ext_vector_type(2)));
        PG8_LAS float* P = (PG8_LAS float*)lds;
        const int col0 = u.pn * BM + wc * 32 + 4 * fq;
#pragma unroll
        for (int ai = 0; ai < 2; ++ai)
#pragma unroll
            for (int m = 0; m < 4; ++m) { const int r = ai * HALF + wr * 64 + m * 16 + fr; const size_t off = (size_t)(u.pm * BM + r) * 1024 + col0; float ss = 0.f;
#pragma unroll
                for (int bj = 0; bj < 2; ++bj)
#pragma unroll
                    for (int n = 0; n < 2; ++n) { const f32x4 bs = *(const f32x4*)(base + off + bj * HALF + n * 16); const f32x4 v = bs + acc[ai][bj][m][n];
                        *(f32x4*)(out + off + bj * HALF + n * 16) = v; ss += (v[0] * v[0] + v[1] * v[1]) + (v[2] * v[2] + v[3] * v[3]);
                        u32x2v w; w.x = cvt_pk_bf16(v[0], v[1]); w.y = cvt_pk_bf16(v[2], v[3]); *(u32x2v*)(xb16 + off + bj * HALF + n * 16) = w; }
                ss += __shfl_xor(ss, 16); ss += __shfl_xor(ss, 32);
                if (fq == 0) P[r * 4 + wc] = ss;
                asm volatile("" ::: "memory"); }
        asm volatile("s_waitcnt lgkmcnt(0)" ::: "memory"); __builtin_amdgcn_s_barrier(); asm volatile("" ::: "memory");
        const int tid = wid * 64 + lane;
        if (tid < 256) ssp[(size_t)(u.pm * BM + tid) * 4 + u.pn] = (P[tid * 4 + 0] + P[tid * 4 + 1]) + (P[tid * 4 + 2] + P[tid * 4 + 3]);
        asm volatile("s_waitcnt lgkmcnt(0)" ::: "memory"); __builtin_amdgcn_s_barrier(); asm volatile("" ::: "memory");
    }
};

struct EpiUp {
    static constexpr bool PERM = true, AFTER_DRAIN = false;
    const float* ssp; const float* cw; const float* cb; bf16_t* ACT; float* HALO;
    PG8_LAS float* stage;
    __device__ __forceinline__ void operator()(const f32x4 (&acc)[2][2][4][2], const Unit& u, int wr, int wc, int fr_, int fq_) const {
        int fr = fr_, fq = fq_; asm volatile("" : "+v"(fr), "+v"(fq));
        const int lane = fq * 16 + fr;
        PG8_LAS float* W = stage + (wr * 4 + wc) * 384;
        PG8_LAS float* R = W + 256;
        const int row00 = u.pm * BM + wr * 64;
        { const int r8 = lane >> 3, c4 = (lane & 7) * 4, k = r8 & 3;
          const float* src = (k < 3 ? cw + (unsigned)(k * 5632) : cb) + (unsigned)((r8 >> 2) * 2816 + u.pn * 128 + wc * 32 + c4);
          const f32x4 wv4 = *(const f32x4*)src;
          const int i0 = lane, i1 = lane + 64;
          const f32x4 q0 = *(const f32x4*)(ssp + (unsigned)((row00 + (i0 & 63)) * 4)), q1 = *(const f32x4*)(ssp + (unsigned)((row00 + 128 + (i1 & 63)) * 4));
          *(PG8_LAS f32x4*)(W + r8 * 32 + c4) = wv4;
          R[i0] = 1.0f / sqrtf(((q0[0] + q0[1]) + (q0[2] + q0[3])) * (1.0f / 1024.0f) + RMS_EPS);
          R[i1] = 1.0f / sqrtf(((q1[0] + q1[1]) + (q1[2] + q1[3])) * (1.0f / 1024.0f) + RMS_EPS); }
        asm volatile("s_waitcnt lgkmcnt(0)" ::: "memory");
        const int chb = u.pn * 128 + wc * 32 + 8 * fq;
        const int row0 = row00 + fr;
        float rs[2][4];
#pragma unroll
        for (int ai = 0; ai < 2; ++ai)
#pragma unroll
            for (int m = 0; m < 4; ++m) rs[ai][m] = R[ai * 64 + m * 16 + fr];
#pragma unroll
        for (int n = 0; n < 2; ++n)
#pragma unroll
            for (int jp = 0; jp < 2; ++jp) {
                const unsigned uc = (unsigned)(chb + 4 * n + 2 * jp);
                const int lc = 8 * fq + 4 * n + 2 * jp;
                float wg[2][4], wv[2][4];
#pragma unroll
                for (int jj = 0; jj < 2; ++jj)
#pragma unroll
                    for (int k = 0; k < 4; ++k) { wg[jj][k] = W[k * 32 + lc + jj]; wv[jj][k] = W[(4 + k) * 32 + lc + jj]; }
#pragma unroll
                for (int ai = 0; ai < 2; ++ai) {
                    const int chunk = u.pm * 4 + ai * 2 + wr;
                    float res[4][2];
#pragma unroll
                    for (int jj = 0; jj < 2; ++jj) {
                        const int j = 2 * jp + jj;
                        float ug[4], uv[4];
#pragma unroll
                        for (int m = 0; m < 4; ++m) { ug[m] = acc[ai][0][m][n][j] * rs[ai][m]; uv[m] = acc[ai][1][m][n][j] * rs[ai][m]; }
                        if (fr < 2) { float* hp = HALO + (unsigned)((chunk * 4 + fr) * 2 * 2816) + (uc + jj); hp[0] = ug[0]; hp[2816] = uv[0]; }
                        if (fr >= 14) { float* hp = HALO + (unsigned)((chunk * 4 + (fr - 12)) * 2 * 2816) + (uc + jj); hp[0] = ug[3]; hp[2816] = uv[3]; }
#pragma unroll
                        for (int m = 0; m < 4; ++m) {
                            float og1 = 0.f, og2 = 0.f, ov1 = 0.f, ov2 = 0.f;
                            if (m > 0) { og1 = dppf<0x121>(0.f, ug[m - 1]); og2 = dppf<0x122>(0.f, ug[m - 1]); ov1 = dppf<0x121>(0.f, uv[m - 1]); ov2 = dppf<0x122>(0.f, uv[m - 1]); }
                            const float g1 = dppf<0x111>(og1, ug[m]), g2 = dppf<0x112>(og2, ug[m]), v1 = dppf<0x111>(ov1, uv[m]), v2 = dppf<0x112>(ov2, uv[m]);
                            const float yg = wg[jj][3] + wg[jj][0] * g2 + wg[jj][1] * g1 + wg[jj][2] * ug[m];
                            const float yv = wv[jj][3] + wv[jj][0] * v2 + wv[jj][1] * v1 + wv[jj][2] * uv[m];
                            res[m][jj] = yg * __builtin_amdgcn_rcpf(1.0f + __expf(-yg)) * yv;
                        }
                    }
#pragma unroll
                    for (int m = 0; m < 4; ++m)
                        if (m > 0 || fr >= 2) *(unsigned*)(ACT + (unsigned)((row0 + ai * HALF + m * 16) * 2816) + uc) = cvt_pk_bf16(res[m][0], res[m][1]);
                    __builtin_amdgcn_sched_barrier(0);
                }
            }
        asm volatile("s_waitcnt lgkmcnt(0)" ::: "memory");
    }
};

struct EpiIn1 {
    static constexpr bool PERM = false, AFTER_DRAIN = false;
    const float* ssp; const float *cosA, *sinA, *cosI, *sinI;
    bf16_t *CAT, *KB, *VT, *IQ, *IK; float* IW;
    __device__ __forceinline__ void operator()(const f32x4 (&acc)[2][2][4][2], const Unit& u, int wr, int wc, int fr_, int fq_) const {
        typedef unsigned u32x2v __attribute__((ext_vector_type(2)));
        int fr = fr_, fq = fq_; asm volatile("" : "+v"(fr), "+v"(fq));
        const int pn = u.pn;
        const int row0 = u.pm * BM + wr * 64 + fr;
#pragma unroll
        for (int ai = 0; ai < 2; ++ai)
#pragma unroll
            for (int m = 0; m < 4; ++m) {
                const int row = row0 + ai * HALF + m * 16; const float rs = rstd4(ssp, row);
                f32x4 v[2][2];
#pragma unroll
                for (int bj = 0; bj < 2; ++bj)
#pragma unroll
                    for (int n = 0; n < 2; ++n) v[bj][n] = acc[ai][bj][m][n] * rs;
                if (pn < 8) {
                    if (wc == 0) { const f32x4 c = *(const f32x4*)(cosA + (size_t)row * 16 + 4 * fq), s = *(const f32x4*)(sinA + (size_t)row * 16 + 4 * fq);
#pragma unroll
                        for (int bj = 0; bj < 2; ++bj) { const f32x4 x1 = v[bj][0], x2 = v[bj][1]; v[bj][0] = x1 * c - x2 * s; v[bj][1] = x2 * c + x1 * s; } }
                    bf16_t* rowp = (pn < 4) ? CAT + (size_t)row * 1536 + pn * 256 : KB + (size_t)row * 1024 + (pn - 4) * 256;
#pragma unroll
                    for (int bj = 0; bj < 2; ++bj)
#pragma unroll
                        for (int n = 0; n < 2; ++n) { u32x2v w; w.x = cvt_pk_bf16(v[bj][n][0], v[bj][n][1]); w.y = cvt_pk_bf16(v[bj][n][2], v[bj][n][3]);
                            *(u32x2v*)(rowp + bj * HALF + wc * 32 + n * 16 + 4 * fq) = w; }
                } else if (pn < 12) {
                    const int b = row >> 11, s = row & 2047;
#pragma unroll
                    for (int bj = 0; bj < 2; ++bj) { const int head = (pn - 8) * 2 + bj;
#pragma unroll
                        for (int n = 0; n < 2; ++n)
#pragma unroll
                            for (int j = 0; j < 4; ++j) { const int d = wc * 32 + n * 16 + 4 * fq + j;
                                VT[(((size_t)b * 8 + head) * 128 + d) * 2048 + s] = (bf16_t)bf1(v[bj][n][j]); } }
                } else if (pn < 14) {
                    bf16_t* rowp = CAT + (size_t)row * 1536 + 1024 + (pn - 12) * 256;
#pragma unroll
                    for (int bj = 0; bj < 2; ++bj)
#pragma unroll
                        for (int n = 0; n < 2; ++n) { u32x2v w; w.x = cvt_pk_bf16(v[bj][n][0], v[bj][n][1]); w.y = cvt_pk_bf16(v[bj][n][2], v[bj][n][3]);
                            *(u32x2v*)(rowp + bj * HALF + wc * 32 + n * 16 + 4 * fq) = w; }
                } else {
                    if ((wc & 1) == 0 && !(pn == 16 && wc >= 2)) { const int fi = 4 * (fq & 1);
                        const f32x4 c = *(const f32x4*)(cosI + (size_t)row * 8 + fi), s = *(const f32x4*)(sinI + (size_t)row * 8 + fi);
#pragma unroll
                        for (int bj = 0; bj < 2; ++bj) { f32x4 p;
#pragma unroll
                            for (int j = 0; j < 4; ++j) p[j] = __shfl_xor(v[bj][0][j], 32);
                            v[bj][0] = (fq < 2) ? (v[bj][0] * c - p * s) : (v[bj][0] * c + p * s); } }
                    if (pn < 16) { bf16_t* rowp = IQ + (size_t)row * 512 + (pn - 14) * 256;
#pragma unroll
                        for (int bj = 0; bj < 2; ++bj)
#pragma unroll
                            for (int n = 0; n < 2; ++n) { u32x2v w; w.x = cvt_pk_bf16(v[bj][n][0], v[bj][n][1]); w.y = cvt_pk_bf16(v[bj][n][2], v[bj][n][3]);
                                *(u32x2v*)(rowp + bj * HALF + wc * 32 + n * 16 + 4 * fq) = w; }
                    } else {
                        if (wc < 2) {
#pragma unroll
                            for (int n = 0; n < 2; ++n) { u32x2v w; w.x = cvt_pk_bf16(v[0][n][0], v[0][n][1]); w.y = cvt_pk_bf16(v[0][n][2], v[0][n][3]);
                                *(u32x2v*)(IK + (size_t)row * 64 + wc * 32 + n * 16 + 4 * fq) = w; }
                        } else if (wc == 2 && fq < 2) { *(f32x4*)(IW + (size_t)row * 8 + 4 * fq) = v[0][0] * 0.35355339059327373f; }
                    }
                }
                __builtin_amdgcn_sched_barrier(0);
            }
    }
};
}
constexpr int NWAVES = 8;
#ifndef MK_N_LAUNCHES
#define MK_N_LAUNCHES 1
#endif
constexpr int N_PHASES = 15;
constexpr int NB = 8, SEQ = 2048, DM = 1024, M = NB * SEQ, MEMT = 256, MMEM = NB * MEMT;
constexpr int DFF = 2816, NUP = 2 * DFF, NIN0 = 2560, NIN1 = 4352, NIN1_SRC = 4168, KCAT = 1536;
constexpr size_t MiB = 1u << 20;
constexpr size_t WS_CTL = 0, CTL_ZERO_BYTES = 64 * 1024;
constexpr size_t WS_WKV = 1 * MiB, WS_WIN0 = 5 * MiB, WS_WOUT0 = 10 * MiB, WS_WOUT1 = 13 * MiB, WS_WUP0 = 16 * MiB, WS_WUP1 = 27 * MiB;
constexpr size_t WS_WDN0 = 38 * MiB, WS_WDN1 = WS_WDN0 + 11 * MiB / 2, WS_WIN1 = 49 * MiB;
constexpr size_t WS_XB16 = 58 * MiB, WS_MEM16 = 90 * MiB, WS_MK = 94 * MiB, WS_MVT = 98 * MiB, WS_SSP = 102 * MiB, WS_SSM = WS_SSP + 512 * 1024;
constexpr size_t WS_COSA = 103 * MiB, WS_SINA = 104 * MiB, WS_COSI = 105 * MiB, WS_SINI = WS_COSI + 512 * 1024, WS_MASK = 106 * MiB, WS_BIG = 110 * MiB;
constexpr size_t WS_XBR = WS_BIG, WS_GBR = WS_BIG + 32 * MiB, WS_CAT0 = WS_BIG + 64 * MiB;
constexpr size_t WS_CAT1 = WS_BIG, WS_KB = WS_BIG + 48 * MiB, WS_VT = WS_BIG + 80 * MiB, WS_IQ = WS_BIG + 112 * MiB, WS_IK = WS_BIG + 128 * MiB, WS_IW = WS_BIG + 130 * MiB;
constexpr size_t WS_ACT = WS_BIG, WS_HALO = WS_BIG + 88 * MiB;
constexpr size_t WS_END = WS_BIG + 131 * MiB;
static_assert(WS_WIN1 + (size_t)NIN1 * DM * 2 <= WS_XB16 && WS_HALO + (size_t)256 * 4 * 2 * DFF * 4 <= WS_END && WS_END <= 256 * MiB, "d_ws map");
constexpr int CW_BAR = 1024;

constexpr int RING_OFF = 0, RING_BYTES = 131072;
constexpr int LDSCTL_OFF = RING_BYTES, MISC_OFF = LDSCTL_OFF + 320;
constexpr int LDS_BYTES = 163840;
constexpr int TOPK_IK_OFF = RING_BYTES + 1024;
#define GAS __attribute__((address_space(1)))
#define LAS __attribute__((address_space(3)))
typedef unsigned short bf16;
typedef unsigned v4u __attribute__((ext_vector_type(4)));
typedef float f32x4 __attribute__((ext_vector_type(4)));
typedef short bf16x8 __attribute__((ext_vector_type(8)));
typedef GAS unsigned gu32;
typedef GAS unsigned long long gu64;
#define RLX_AGENT __ATOMIC_RELAXED, __HIP_MEMORY_SCOPE_AGENT
#define LDS_WAIT() asm volatile("s_waitcnt lgkmcnt(0)" ::: "memory")
#define VM_WAIT() asm volatile("s_waitcnt vmcnt(0)" ::: "memory")
__device__ __forceinline__ unsigned long long rt() { return __builtin_amdgcn_s_memrealtime(); }
__device__ __forceinline__ unsigned f2bf(float f) { unsigned u = __builtin_bit_cast(unsigned, f); return (u + 0x7fffu + ((u >> 16) & 1u)) >> 16; }
__device__ __forceinline__ unsigned pk2(float lo, float hi) { return f2bf(lo) | (f2bf(hi) << 16); }
#define XB_TMO      128
#define XB_XCNT(j)  (256  + 64 * (j))
#define XB_XSUB(j)  (1280 + 64 * (j))
#define XB_XGEN(j)  (2304 + 64 * (j))
#define XB_TOP      3328
#define XB_TOPGEN   3392
#define XCD_BAR_WORDS 3456
#define XB_SPIN_CAP (1u << 18)

__device__ __forceinline__ unsigned xb_ld(unsigned* p)              { return __hip_atomic_load(p, __ATOMIC_RELAXED, __HIP_MEMORY_SCOPE_AGENT); }
__device__ __forceinline__ unsigned xb_add(unsigned* p, unsigned v) { return __hip_atomic_fetch_add(p, v, __ATOMIC_RELAXED, __HIP_MEMORY_SCOPE_AGENT); }
__device__ __forceinline__ unsigned xb_xcc_id() { return (unsigned)__builtin_amdgcn_s_getreg((3 << 11) | 20) & 0xFu; }
#define XB_SPIN(cond, bar) do { unsigned _sp = 0; while (cond) { __builtin_amdgcn_s_sleep(1); \
    if ((++_sp & 255u) == 0u) { if (xb_ld(&(bar)[XB_TMO])) break; if (_sp > XB_SPIN_CAP) { atomicAdd(&(bar)[XB_TMO], 1u); break; } } } } while (0)

struct XcdBarrier {
    unsigned* bar; unsigned x;
    volatile LAS unsigned* st;
};

__device__ __forceinline__ XcdBarrier xcd_barrier_post(unsigned* bar, volatile LAS unsigned* st) {
    XcdBarrier b; b.bar = bar; b.x = xb_xcc_id(); b.st = st;
    if (threadIdx.x == 0) (void)xb_add(&bar[XB_XCNT(b.x)], 1u);
    return b;
}
__device__ __forceinline__ void xcd_barrier_complete(unsigned* bar, unsigned x, unsigned& nloc, unsigned& nx) {
    const unsigned G = gridDim.x * gridDim.y * gridDim.z;
    unsigned sum, cnt, mine, sp = 0u;
    for (;;) {
        sum = 0u; cnt = 0u; mine = 0u;
#pragma unroll
        for (unsigned j = 0; j < 16; ++j) { const unsigned c = xb_ld(&bar[XB_XCNT(j)]); sum += c; cnt += (c > 0u) ? 1u : 0u; mine = (j == x) ? c : mine; }
        if (sum == G) break;
        __builtin_amdgcn_s_sleep(1);
        if ((++sp & 255u) == 0u) { if (xb_ld(&bar[XB_TMO])) break; if (sp > XB_SPIN_CAP) { atomicAdd(&bar[XB_TMO], 1u); break; } }
    }
    nloc = mine > 0u ? mine : 1u; nx = cnt > 0u ? cnt : 1u;
}

__device__ __forceinline__ void xcd_barrier(const XcdBarrier& b) {
    asm volatile("s_waitcnt vmcnt(0)" ::: "memory");
    __syncthreads();
    if (threadIdx.x == 0) {
        unsigned* bar = b.bar;
        __builtin_amdgcn_s_waitcnt(0);
        unsigned nloc = b.st[0], nx = b.st[1];
        if (nloc == 0u) { xcd_barrier_complete(bar, b.x, nloc, nx); b.st[0] = nloc; b.st[1] = nx; }
        const unsigned old = xb_add(&bar[XB_XSUB(b.x)], 1u);
        const unsigned gen = old / nloc;
        if (old + 1u == (gen + 1u) * nloc) {
            __builtin_amdgcn_fence(__ATOMIC_RELEASE, "agent");
            asm volatile("s_waitcnt vmcnt(0)" ::: "memory");
            const unsigned og = xb_add(&bar[XB_TOP], 1u);
            const unsigned tg = og / nx;
            if (og + 1u == (tg + 1u) * nx) xb_add(&bar[XB_TOPGEN], 1u);
            else XB_SPIN(xb_ld(&bar[XB_TOPGEN]) == tg, bar);
            __builtin_amdgcn_fence(__ATOMIC_ACQUIRE, "agent");
            xb_add(&bar[XB_XGEN(b.x)], 1u);
            asm volatile("s_waitcnt vmcnt(0)" ::: "memory");
        } else {
            XB_SPIN(xb_ld(&bar[XB_XGEN(b.x)]) == gen, bar);
            __builtin_amdgcn_fence(__ATOMIC_ACQUIRE, "agent");
            asm volatile("s_waitcnt vmcnt(0)" ::: "memory");
        }
    }
    __syncthreads();
}
typedef float f32x16 __attribute__((ext_vector_type(16)));
typedef unsigned u32x2 __attribute__((ext_vector_type(2)));
using pg8::cvt_pk_bf16;
__device__ __forceinline__ float wave_sum(float v) {
#pragma unroll
    for (int o = 1; o < 64; o <<= 1) v += __shfl_xor(v, o);
    return v;
}
__device__ __forceinline__ unsigned cvt_pk_bf16_mfma(float lo, float hi) { unsigned r; asm volatile("v_cvt_pk_bf16_f32 %0, %1, %2\n\ts_nop 1" : "=v"(r) : "v"(lo), "v"(hi)); return r; }
__device__ __forceinline__ bf16x8 pack8(const float* p) { v4u w; w.x = cvt_pk_bf16_mfma(p[0], p[1]); w.y = cvt_pk_bf16_mfma(p[2], p[3]); w.z = cvt_pk_bf16_mfma(p[4], p[5]); w.w = cvt_pk_bf16_mfma(p[6], p[7]); return __builtin_bit_cast(bf16x8, w); }
__device__ __forceinline__ float bf2f(bf16 v) { return __builtin_bit_cast(float, (unsigned)v << 16); }
__device__ __forceinline__ float sigmoidf_(float x) { return __builtin_amdgcn_rcpf(1.0f + __expf(-x)); }

__device__ __forceinline__ void p0_transpose_item(const float* W, int Nsrc, const float* g, bf16* WT, int K, int k0, int n0, int s0, int nvalid, LAS bf16* scr, int lane) {
    float v[64];
    const float* wp = W + (size_t)k0 * Nsrc + s0 + lane;
    const bool ok = lane < nvalid;
#pragma unroll
    for (int i = 0; i < 64; ++i) v[i] = ok ? wp[(size_t)i * Nsrc] : 0.f;
    if (g) {
#pragma unroll
        for (int i = 0; i < 64; ++i) v[i] *= g[k0 + i];
    }
#pragma unroll
    for (int i = 0; i < 64; ++i) scr[i * 66 + lane] = (bf16)pg8::bf1(v[i]);
    LDS_WAIT(); asm volatile("" ::: "memory");
    const int c = lane & 7;
#pragma unroll
    for (int j = 0; j < 8; ++j) { const int n = (lane >> 3) + 8 * j; const LAS bf16* s = scr + (8 * c) * 66 + n;
        v4u o; o.x = (unsigned)s[0] | ((unsigned)s[66] << 16); o.y = (unsigned)s[2 * 66] | ((unsigned)s[3 * 66] << 16);
        o.z = (unsigned)s[4 * 66] | ((unsigned)s[5 * 66] << 16); o.w = (unsigned)s[6 * 66] | ((unsigned)s[7 * 66] << 16);
        *(v4u*)(WT + (size_t)(n0 + n) * K + k0 + 8 * c) = o; }
    LDS_WAIT(); asm volatile("" ::: "memory");
}
struct Ptrs {
    const float *x, *mem; const int* pos; const float *norm_mix, *norm_ffn, *mem_norm, *final_norm, *w_mem_kv, *w_ffn_up, *ffn_conv_w, *ffn_conv_b, *w_ffn_down;
    const float *lru_w_in, *lru_conv_w, *lru_conv_b, *lru_w_a, *lru_b_a, *lru_w_x, *lru_b_x, *lru_lambda, *lru_w_out, *dsa_w_in, *dsa_w_out;
    float* out; unsigned char* ws;
};
__device__ __forceinline__ void p0_prologue(const Ptrs& P, LAS unsigned char* lds, int gw, int NGW, int wave, int lane) {
    LAS bf16* scr = (LAS bf16*)(lds + wave * 16384);
    unsigned char* ws = P.ws;
    constexpr int I_KV = 16 * 32, I_IN0 = 16 * 40, I_OUT = 24 * 16, I_UP = 16 * 88, I_DN = 44 * 16, I_IN1 = 16 * 68;
    constexpr int NITEMS = I_KV + I_IN0 + 2 * I_OUT + 2 * I_UP + 2 * I_DN + I_IN1;
    for (int it = gw; it < NITEMS; it += NGW) {
        int r = it;
        if (r < I_KV) { const int kb = r / 32, nb = r % 32, l = nb / 16;
            p0_transpose_item(P.w_mem_kv + (size_t)l * 1024 * 1024, 1024, P.mem_norm, (bf16*)(ws + WS_WKV), 1024, kb * 64, nb * 64, (nb % 16) * 64, 64, scr, lane); continue; } r -= I_KV;
        if (r < I_IN0) { const int kb = r / 40, nb = r % 40;
            p0_transpose_item(P.lru_w_in, NIN0, P.norm_mix, (bf16*)(ws + WS_WIN0), 1024, kb * 64, nb * 64, nb * 64, 64, scr, lane); continue; } r -= I_IN0;
        if (r < 2 * I_OUT) { const int l = r / I_OUT, q = r % I_OUT, kb = q / 16, nb = q % 16;
            p0_transpose_item(l ? P.dsa_w_out : P.lru_w_out, 1024, nullptr, (bf16*)(ws + (l ? WS_WOUT1 : WS_WOUT0)), KCAT, kb * 64, nb * 64, nb * 64, 64, scr, lane); continue; } r -= 2 * I_OUT;
        if (r < 2 * I_UP) { const int l = r / I_UP, q = r % I_UP, kb = q / 88, nb = q % 88;
            const int tile = nb / 4, half = (nb % 4) / 2, j0 = (nb % 2) * 64;
            p0_transpose_item(P.w_ffn_up + (size_t)l * 1024 * NUP, NUP, P.norm_ffn + l * 1024, (bf16*)(ws + (l ? WS_WUP1 : WS_WUP0)), 1024, kb * 64, nb * 64, half * DFF + tile * 128 + j0, 64, scr, lane); continue; } r -= 2 * I_UP;
        if (r < 2 * I_DN) { const int l = r / I_DN, q = r % I_DN, kb = q / 16, nb = q % 16;
            p0_transpose_item(P.w_ffn_down + (size_t)l * DFF * 1024, 1024, nullptr, (bf16*)(ws + (l ? WS_WDN1 : WS_WDN0)), DFF, kb * 64, nb * 64, nb * 64, 64, scr, lane); continue; } r -= 2 * I_DN;
        { const int kb = r / 68, nb = r % 68, n0 = nb * 64; int s0, nv = 64;
            if (n0 < 3072) s0 = n0; else if (n0 < 3584) s0 = 3656 + (n0 - 3072); else if (n0 < 4096) s0 = 3072 + (n0 - 3584); else if (n0 < 4160) s0 = 3584 + (n0 - 4096);
            else if (n0 == 4160) { s0 = 3648; nv = 8; } else { s0 = 0; nv = 0; }
            p0_transpose_item(P.dsa_w_in, NIN1_SRC, P.norm_mix + 1024, (bf16*)(ws + WS_WIN1), 1024, kb * 64, n0, s0, nv, scr, lane); }
    }
    float* ssp = (float*)(ws + WS_SSP); float* ssm = (float*)(ws + WS_SSM);
    for (int m0 = gw; m0 < M + MMEM; m0 += 3 * NGW) {
        f32x4 v[3][4]; float s[3];
#pragma unroll
        for (int k = 0; k < 3; ++k) { const int m = m0 + k * NGW; if (m < M + MMEM) { const bool is_x = m < M; const int r = is_x ? m : m - M;
                const f32x4* xr = (const f32x4*)((is_x ? P.x : P.mem) + (size_t)r * DM) + lane;
#pragma unroll
                for (int j = 0; j < 4; ++j) v[k][j] = xr[64 * j]; } }
#pragma unroll
        for (int k = 0; k < 3; ++k) { const int m = m0 + k * NGW; if (m < M + MMEM) { const bool is_x = m < M; const int r = is_x ? m : m - M;
                unsigned long long* o8 = (unsigned long long*)((bf16*)(ws + (is_x ? WS_XB16 : WS_MEM16)) + (size_t)r * DM) + lane;
                float sq = 0.f;
#pragma unroll
                for (int j = 0; j < 4; ++j) { const f32x4 t = v[k][j]; sq += (t.x * t.x + t.y * t.y) + (t.z * t.z + t.w * t.w);
                    o8[64 * j] = (unsigned long long)cvt_pk_bf16(t.x, t.y) | ((unsigned long long)cvt_pk_bf16(t.z, t.w) << 32); }
                s[k] = wave_sum(sq);
                if (lane == 0) { if (is_x) { *(f32x4*)(ssp + (size_t)r * 4) = (f32x4){s[k], 0.f, 0.f, 0.f}; } else ssm[r] = s[k]; } } }
    }
    float *cosA = (float*)(ws + WS_COSA), *sinA = (float*)(ws + WS_SINA), *cosI = (float*)(ws + WS_COSI), *sinI = (float*)(ws + WS_SINI);
    for (int e = gw * 64 + lane; e < M * 24; e += NGW * 64) {
        const int row = e / 24, i = e % 24; const double p = (double)P.pos[row];
        const int fi = i < 16 ? i : 2 * (i - 16);
        double inv = 1.0;
        switch (fi) { case 1: inv = 0.44036660267178046; break; case 2: inv = 0.19392274474868576; break; case 3: inv = 0.085397100285765609; break; case 4: inv = 0.037606030930863933; break;
            case 5: inv = 0.016560440080994446; break; case 6: inv = 0.0072926647372171093; break; case 7: inv = 0.0032114459947525909; break; case 8: inv = 0.001414213562373095; break;
            case 9: inv = 0.00062277242191459599; break; case 10: inv = 0.0002742481756762073; break; case 11: inv = 0.00012076973741146504; break; case 12: inv = 5.3182958969449883e-05; break;
            case 13: inv = 2.3419998961409342e-05; break; case 14: inv = 1.031338537721246e-05; break; case 15: inv = 4.5416704806078695e-06; break; default: break; }
        const double a = p * inv; const float cv = (float)cos(a), sv = (float)sin(a);
        if (i < 16) { cosA[row * 16 + i] = cv; sinA[row * 16 + i] = sv; } else { cosI[row * 8 + (i - 16)] = cv; sinI[row * 8 + (i - 16)] = sv; }
    }
}
template <bool MASKED>
__device__ __forceinline__ void attn_block(LAS unsigned char* lds, const bf16* Q, int qpitch, const bf16* K, int kpitch, const bf16* VT, int vtpitch, int nt, int last_tile,
                                           const unsigned* mask, bf16* O, int opitch, int tid, int lane) {
    const int qrow = lane & 31, hi = lane >> 5;
    bf16x8 qf[8];
#pragma unroll
    for (int s = 0; s < 8; ++s) qf[s] = *(const bf16x8*)(Q + (size_t)qrow * qpitch + 16 * s + 8 * hi);
    f32x16 oacc[4];
#pragma unroll
    for (int dt = 0; dt < 4; ++dt)
#pragma unroll
        for (int r = 0; r < 16; ++r) oacc[dt][r] = 0.f;
    float mrun = -1e30f, lrun = 0.f;
    const float cs = 1.4426950408889634f * 0.08838834764831845f;
    const int kkey = tid >> 4, kch = tid & 15, vd = tid >> 2, vch = tid & 3;
    const unsigned kdst = (unsigned)(kkey * 256 + ((kch ^ (kkey & 15)) << 4)), vdst = (unsigned)(16384 + vd * 64 + ((vch ^ ((vd >> 2) & 3)) << 4));
    const bf16* kg = K + (size_t)kkey * kpitch + kch * 8;
    const bf16* vg = VT + (size_t)vd * vtpitch + vch * 8;
    const int i5 = lane & 31, keyl = (i5 & ~12) | ((i5 & 4) << 1) | ((i5 & 8) >> 1);
    const unsigned kbase = (unsigned)(keyl * 256), kx = (unsigned)(keyl & 15), vbase = (unsigned)(16384 + i5 * 64), vx = (unsigned)((i5 >> 2) & 3);
    v4u kr = *(const v4u*)kg, vr = *(const v4u*)vg;
    __syncthreads();
    *(LAS v4u*)(lds + kdst) = kr; *(LAS v4u*)(lds + vdst) = vr;
    unsigned mw_next = 0xffffffffu;
    if (MASKED) mw_next = mask[(size_t)qrow * 64];
    LDS_WAIT(); __syncthreads();
    for (int kt = 0; kt < nt; ++kt) {
        const unsigned bo = (unsigned)((kt & 1) * 8192);
        const bool more = kt + 1 < nt;
        if (more) { kr = *(const v4u*)(kg + (size_t)(kt + 1) * 32 * kpitch); vr = *(const v4u*)(vg + (kt + 1) * 32); }
        unsigned mw = mw_next;
        if (MASKED && kt + 1 <= last_tile) mw_next = mask[(size_t)qrow * 64 + kt + 1];
        if (kt <= last_tile) {
            f32x16 sacc;
#pragma unroll
            for (int r = 0; r < 16; ++r) sacc[r] = 0.f;
#pragma unroll
            for (int s = 0; s < 8; ++s) { const bf16x8 kf = *(const LAS bf16x8*)(lds + bo + kbase + ((((unsigned)(2 * s + hi)) ^ kx) << 4));
                sacc = __builtin_amdgcn_mfma_f32_32x32x16_bf16(kf, qf[s], sacc, 0, 0, 0); }
            mw >>= (8 * hi);
            float mx = -1e30f;
#pragma unroll
            for (int r = 0; r < 16; ++r) { const int sh = (r & 3) + 4 * ((r >> 2) & 1) + 16 * (r >> 3); const bool sel = !MASKED || ((mw >> sh) & 1u);
                sacc[r] = sel ? sacc[r] * cs : -1e30f; mx = fmaxf(mx, sacc[r]); }
            mx = fmaxf(mx, __shfl_xor(mx, 32));
            const float mnew = fmaxf(mrun, mx);
            const float alpha = __builtin_amdgcn_exp2f(mrun - mnew);
            mrun = mnew;
            float p[16]; float ps = 0.f;
#pragma unroll
            for (int r = 0; r < 16; ++r) { p[r] = (sacc[r] > -1e29f) ? __builtin_amdgcn_exp2f(sacc[r] - mnew) : 0.f; ps += p[r]; }
            lrun = lrun * alpha + ps;
            if (!__all(alpha == 1.0f)) {
#pragma unroll
                for (int dt = 0; dt < 4; ++dt)
#pragma unroll
                    for (int r = 0; r < 16; ++r) oacc[dt][r] *= alpha;
            }
            bf16x8 pb[2];
            pb[0] = pack8(p); pb[1] = pack8(p + 8);
#pragma unroll
            for (int dt = 0; dt < 4; ++dt)
#pragma unroll
                for (int s2 = 0; s2 < 2; ++s2) { const bf16x8 vf = *(const LAS bf16x8*)(lds + bo + vbase + (unsigned)(dt * 2048) + ((((unsigned)(2 * s2 + hi)) ^ vx) << 4));
                    oacc[dt] = __builtin_amdgcn_mfma_f32_32x32x16_bf16(vf, pb[s2], oacc[dt], 0, 0, 0); }
        }
        if (more) { *(LAS v4u*)(lds + (bo ^ 8192u) + kdst) = kr; *(LAS v4u*)(lds + (bo ^ 8192u) + vdst) = vr; }
        LDS_WAIT(); __syncthreads();
    }
    const float ltot = lrun + __shfl_xor(lrun, 32);
    const float inv = __builtin_amdgcn_rcpf(ltot);
#pragma unroll
    for (int dt = 0; dt < 4; ++dt)
#pragma unroll
        for (int g4 = 0; g4 < 4; ++g4) { u32x2 w; w.x = cvt_pk_bf16(oacc[dt][4 * g4] * inv, oacc[dt][4 * g4 + 1] * inv); w.y = cvt_pk_bf16(oacc[dt][4 * g4 + 2] * inv, oacc[dt][4 * g4 + 3] * inv);
            *(u32x2*)(O + (size_t)qrow * opitch + 32 * dt + 8 * g4 + 4 * hi) = w; }
}
__device__ __forceinline__ void memattn_block(unsigned char* ws, LAS unsigned char* lds, int l, bf16* CAT, int u, int tid, int wave, int lane) {
    const int qb = u & 7, h = (u >> 3) & 3, b = u >> 5;
    bf16* q = CAT + (size_t)(b * SEQ + qb * 256 + wave * 32) * KCAT + 1024 + h * 128;
    const bf16* k = (const bf16*)(ws + WS_MK) + ((size_t)l * MMEM + b * MEMT) * 512 + h * 128;
    const bf16* vt = (const bf16*)(ws + WS_MVT) + (((size_t)l * 8 + b) * 4 + h) * 128 * 256;
    attn_block<false>(lds, q, KCAT, k, 512, vt, 256, 8, 7, nullptr, q, KCAT, tid, lane);
}
__device__ __forceinline__ void dsa_block(unsigned char* ws, LAS unsigned char* lds, int u, int tid, int wave, int lane) {
    const int qb = u & 7, h = (u >> 3) & 7, b = u >> 6;
    const int qt = qb * 8 + wave;
    bf16* q = (bf16*)(ws + WS_CAT1) + (size_t)(b * SEQ + qt * 32) * KCAT + h * 128;
    const bf16* k = (const bf16*)(ws + WS_KB) + (size_t)(b * SEQ) * 1024 + h * 128;
    const bf16* vt = (const bf16*)(ws + WS_VT) + ((size_t)b * 8 + h) * 128 * 2048;
    const unsigned* mk = (const unsigned*)(ws + WS_MASK) + (size_t)(b * SEQ + qt * 32) * 64;
    attn_block<true>(lds, q, KCAT, k, 1024, vt, 2048, qb * 8 + 8, qt, mk, q, KCAT, tid, lane);
}

__device__ __forceinline__ unsigned mono_key(float s) { unsigned b = __builtin_bit_cast(unsigned, s); if ((b << 1) == 0u) b = 0u; return (b & 0x80000000u) ? ~b : (b | 0x80000000u); }
__device__ __forceinline__ int half_sum(int v) {
#pragma unroll
    for (int o = 1; o < 32; o <<= 1) v += __shfl_xor(v, o);
    return v;
}
__device__ __forceinline__ int half_total(int v, int hi) {
    v += __builtin_amdgcn_update_dpp(0, v, 0x111, 0xf, 0xf, true);
    v += __builtin_amdgcn_update_dpp(0, v, 0x112, 0xf, 0xf, true);
    v += __builtin_amdgcn_update_dpp(0, v, 0x114, 0xf, 0xf, true);
    v += __builtin_amdgcn_update_dpp(0, v, 0x118, 0xf, 0xf, true);
    v += __builtin_amdgcn_update_dpp(0, v, 0x142, 0xa, 0xf, true);
    const int lo = __builtin_amdgcn_readlane(v, 31), up = __builtin_amdgcn_readlane(v, 63);
    return hi ? up : lo;
}
__device__ __forceinline__ void topk_select(const unsigned (&U)[64], unsigned* mrow_ptr, int tq, int ntile, int lane) {
    const int c = lane & 31, hi = lane >> 5;
    const bool all_valid = (tq + 1 <= 256);
    bool done = all_valid; unsigned T = all_valid ? 1u : 0u;
#pragma unroll 1
    for (int bit = 31; bit >= 0; --bit) {
        if (__all(done)) break;
        const unsigned cand = T | (1u << bit); int cv = 0;
#pragma unroll
        for (int kt = 0; kt < 64; ++kt) cv += (U[kt] >= cand) ? 1 : 0;
        const int cnt = half_total(cv, hi);
        if (!done) { if (cnt >= 256) T = cand; if (cnt == 256) done = true; }
    }
    int gev = 0;
#pragma unroll
    for (int kt = 0; kt < 64; ++kt) gev += (U[kt] >= T) ? 1 : 0;
    const int nge = half_total(gev, hi);
    int mrow0 = 0, mrow1 = 0; int lk = lane;
    if (__all(all_valid || nge == 256)) {
#pragma unroll
        for (int kt = 0; kt < 64; ++kt) { const unsigned long long wb = __ballot(U[kt] >= T);
            mrow0 = (lk == 0) ? (int)(unsigned)wb : mrow0; mrow1 = (lk == 0) ? (int)(unsigned)(wb >> 32) : mrow1; lk -= 1; asm volatile("" : "+v"(lk)); }
    } else {
        int gv = 0;
#pragma unroll
        for (int kt = 0; kt < 64; ++kt) gv += (U[kt] > T) ? 1 : 0;
        const int ngt = half_total(gv, hi);
        const int need = all_valid ? 0x7fffffff : 256 - ngt;
        int eqc = 0; const unsigned lt = (1u << c) - 1u;
#pragma unroll
        for (int kt = 0; kt < 64; ++kt) {
            const bool eq = U[kt] == T, gt = U[kt] > T;
            const unsigned long long bal = __ballot(eq); const unsigned hbm = hi ? (unsigned)(bal >> 32) : (unsigned)bal;
            const int rank = __popc(hbm & lt);
            const bool sel = gt || (eq && (eqc + rank < need));
            eqc += __popc(hbm);
            const unsigned long long wb = __ballot(sel);
            mrow0 = (lk == 0) ? (int)(unsigned)wb : mrow0; mrow1 = (lk == 0) ? (int)(unsigned)(wb >> 32) : mrow1; lk -= 1; asm volatile("" : "+v"(lk));
        }
    }
    if (lane < ntile) { mrow_ptr[lane] = (unsigned)mrow0; mrow_ptr[2 * 64 + lane] = (unsigned)mrow1; }
}
__device__ __forceinline__ void topk_block(unsigned char* ws, LAS unsigned char* lds, int u0, int slot, int tid, int wave, int lane) {
    const int u = slot ? 4095 - (u0 + wave) : u0 + wave;
    const int ubig = slot ? 4095 - u0 : u0 + 7;
    const int b = u >> 9, t0 = (u & 511) * 4;
    const int c = lane & 31, hi = lane >> 5;
    const bf16* IQ = (const bf16*)(ws + WS_IQ); const bf16* IK = (const bf16*)(ws + WS_IK); const float* IW = (const float*)(ws + WS_IW);
    bf16x8 af[4];
    { const int i = c, qi = t0 + 2 * ((i >> 2) & 1) + ((i >> 4) & 1), hd = (i & 3) | (((i >> 3) & 1) << 2);
      const bf16* ap = IQ + (size_t)(b * SEQ + qi) * 512 + hd * 64 + 8 * hi;
#pragma unroll
      for (int s = 0; s < 4; ++s) af[s] = *(const bf16x8*)(ap + 16 * s); }
    float w[2][8];
#pragma unroll
    for (int jj = 0; jj < 2; ++jj) { const float* wp = IW + (size_t)(b * SEQ + t0 + 2 * hi + jj) * 8;
#pragma unroll
        for (int h = 0; h < 8; ++h) w[jj][h] = wp[h] * 0.125f; }
    const int ntile = (t0 + 3) / 32 + 1;
    const int nstep = ((((ubig & 511) * 4 + 3) / 32 + 1) + 1) >> 1;
    unsigned U0[64];
    LAS unsigned* sc1 = (LAS unsigned*)(lds + wave * 16384) + hi * 2048 + c;
    {
        LAS unsigned char* ikb = lds + TOPK_IK_OFF;
        const int lk = tid >> 3, lch = tid & 7;
        const unsigned wdst = (unsigned)(lk * 128 + ((lch ^ ((lk >> 1) & 7)) << 4));
        const unsigned char* ikbase = (const unsigned char*)(IK + (size_t)(b * SEQ) * 64);
        unsigned goff = (unsigned)tid * 16u;
        unsigned roff[2][4];
#pragma unroll
        for (int q = 0; q < 2; ++q)
#pragma unroll
            for (int s = 0; s < 4; ++s) { const int key = q * 32 + c; roff[q][s] = (unsigned)(key * 128 + (((2 * s + hi) ^ ((key >> 1) & 7)) << 4)); }
        int keyv = c;
        v4u stg = *(const v4u*)(ikbase + goff);
        __syncthreads();
        *(LAS v4u*)(ikb + wdst) = stg;
        LDS_WAIT(); __syncthreads();
#pragma unroll
        for (int st = 0; st < 32; ++st) {
            if (st < nstep) {
                const unsigned bo = (unsigned)((st & 1) * 8192);
                const bool more = st + 1 < nstep;
                goff += 8192u; asm volatile("" : "+v"(goff));
                if (more) stg = *(const v4u*)(ikbase + goff);
#pragma unroll
                for (int q = 0; q < 2; ++q) { const int kt = 2 * st + q; const int key = keyv; keyv += 32; asm volatile("" : "+v"(keyv));
                    f32x16 acc;
#pragma unroll
                    for (int r = 0; r < 16; ++r) acc[r] = 0.f;
#pragma unroll
                    for (int s = 0; s < 4; ++s) acc = __builtin_amdgcn_mfma_f32_32x32x16_bf16(af[s], *(const LAS bf16x8*)(ikb + bo + roff[q][s]), acc, 0, 0, 0);
                    float s0 = 0.f, s1 = 0.f;
#pragma unroll
                    for (int h = 0; h < 8; ++h) { s0 += w[0][h] * fmaxf(acc[h], 0.f); s1 += w[1][h] * fmaxf(acc[8 + h], 0.f); }
                    U0[kt] = (key <= t0 + 2 * hi) ? mono_key(s0) : 0u; sc1[kt * 32] = (key <= t0 + 2 * hi + 1) ? mono_key(s1) : 0u; }
                if (more) *(LAS v4u*)(ikb + (bo ^ 8192u) + wdst) = stg;
                LDS_WAIT(); __syncthreads();
            } else { U0[2 * st] = 0u; U0[2 * st + 1] = 0u; sc1[(2 * st) * 32] = 0u; sc1[(2 * st + 1) * 32] = 0u; }
            __builtin_amdgcn_sched_barrier(0);
        }
    }
    unsigned* MASK = (unsigned*)(ws + WS_MASK);
    topk_select(U0, MASK + (size_t)(b * SEQ + t0) * 64, t0 + 2 * hi, ntile, lane);
    LDS_WAIT(); asm volatile("" ::: "memory");
#pragma unroll
    for (int kt = 0; kt < 64; ++kt) U0[kt] = sc1[kt * 32];
    topk_select(U0, MASK + (size_t)(b * SEQ + t0 + 1) * 64, t0 + 2 * hi + 1, ntile, lane);
    LDS_WAIT(); asm volatile("" ::: "memory");
}
__device__ __forceinline__ void lru_item(const Ptrs& P, LAS unsigned char* lds, int b, int n, int half, int tid, int wave, int lane) {
    unsigned char* ws = P.ws;
    const bf16* XBR = (const bf16*)(ws + WS_XBR); const bf16* GBR = (const bf16*)(ws + WS_GBR); bf16* CAT = (bf16*)(ws + WS_CAT0);
    LAS bf16* WAt = (LAS bf16*)lds;
    LAS bf16* WXt = (LAS bf16*)(lds + 4608);
    LAS float* SUM = (LAS float*)(lds + 9216);
    LAS float* XC = (LAS float*)(lds + 16384 + wave * 8320);
    for (int e = tid; e < 2048; e += 512) { const int in = e >> 5, out = e & 31;
        WAt[out * 72 + in] = (bf16)pg8::bf1(P.lru_w_a[((size_t)n * 64 + in) * 64 + 32 * half + out]);
        WXt[out * 72 + in] = (bf16)pg8::bf1(P.lru_w_x[((size_t)n * 64 + in) * 64 + 32 * half + out]); }
    __syncthreads();
    const int c = lane & 31, hi = lane >> 5;
    const int ch = n * 64 + 32 * half + c;
    const float ba = P.lru_b_a[ch], bx = P.lru_b_x[ch], sp = log1pf(__expf(-P.lru_lambda[ch]));
    const int chl = n * 64 + lane;
    const float cw0 = P.lru_conv_w[chl], cw1 = P.lru_conv_w[1024 + chl], cw2 = P.lru_conv_w[2048 + chl], cw3 = P.lru_conv_w[3072 + chl], cb = P.lru_conv_b[chl];
    float R = 0.f;
    bf16 xr[35], gr[16];
#define LRU_LOADS(round_) do { const int tb_ = (round_) * 256 + wave * 32; const size_t rowb_ = (size_t)b * SEQ + tb_; \
        const bf16* xp = XBR + rowb_ * 1024 + chl; \
        _Pragma("unroll") for (int tt = 0; tt < 35; ++tt) xr[tt] = (tt >= 3 || tb_ > 0) ? xp[(tt - 3) * 1024] : (bf16)0; \
        const bf16* gp = GBR + rowb_ * 1024 + ch; \
        _Pragma("unroll") for (int r = 0; r < 16; ++r) gr[r] = gp[((r & 3) + 8 * (r >> 2) + 4 * hi) * 1024]; } while (0)
    LRU_LOADS(0);
    for (int round = 0; round < 8; ++round) {
        const int tb = round * 256 + wave * 32;
        const size_t rowb = (size_t)b * SEQ + tb;
#pragma unroll
        for (int tt = 0; tt < 32; ++tt)
            XC[tt * 65 + lane] = cb + cw0 * bf2f(xr[tt]) + cw1 * bf2f(xr[tt + 1]) + cw2 * bf2f(xr[tt + 2]) + cw3 * bf2f(xr[tt + 3]);
        LDS_WAIT(); asm volatile("" ::: "memory");
        f32x16 accA, accX;
#pragma unroll
        for (int r = 0; r < 16; ++r) { accA[r] = 0.f; accX[r] = 0.f; }
#pragma unroll
        for (int s = 0; s < 4; ++s) { float t8[8];
#pragma unroll
            for (int j = 0; j < 8; ++j) t8[j] = XC[c * 65 + 16 * s + 8 * hi + j];
            const bf16x8 af = pack8(t8);
            const bf16x8 wa = *(const LAS bf16x8*)(WAt + c * 72 + 16 * s + 8 * hi), wx = *(const LAS bf16x8*)(WXt + c * 72 + 16 * s + 8 * hi);
            accA = __builtin_amdgcn_mfma_f32_32x32x16_bf16(af, wa, accA, 0, 0, 0); accX = __builtin_amdgcn_mfma_f32_32x32x16_bf16(af, wx, accX, 0, 0, 0); }
        float hloc[16], pl[16], gg[16];
        const int par = round & 1;
        {
            float Ag[4], Hg[4];
#pragma unroll
            for (int g = 0; g < 4; ++g) { float h = 0.f, p = 1.f;
#pragma unroll
                for (int j = 0; j < 4; ++j) { const int r = 4 * g + j, tok = j + 8 * g + 4 * hi;
                    const float xc = XC[tok * 65 + 32 * half + c];
                    const float gb = bf2f(gr[r]);
                    const float rg = sigmoidf_(accA[r] + ba), ig = sigmoidf_(accX[r] + bx);
                    const float la = -8.0f * rg * sp, a = __expf(la), z = 2.0f * la;
                    const float em = (z > -0.05f) ? -z * (1.0f + z * (0.5f + z * (0.16666667f + z * 0.041666667f))) : 1.0f - __expf(z);
                    const float bt = sqrtf(em) * (ig * xc);
                    h = a * h + bt; p = p * a; hloc[r] = h; pl[r] = p;
                    const float u2 = 1.5957691216057308f * (gb + 0.044715f * gb * gb * gb);
                    gg[r] = gb * sigmoidf_(u2); }
                Ag[g] = p; Hg[g] = h; }
            float cc = 0.f, qq = 1.f;
#pragma unroll
            for (int g = 0; g < 4; ++g) { const float Ap = __shfl_xor(Ag[g], 32), Hp = __shfl_xor(Hg[g], 32);
                const float fA = hi ? Ap : Ag[g], fH = hi ? Hp : Hg[g], sA = hi ? Ag[g] : Ap, sH = hi ? Hg[g] : Hp;
                const float c1 = fA * cc + fH, q1 = qq * fA;
                const float hin = hi ? c1 : cc, pin = hi ? q1 : qq;
                cc = sA * c1 + sH; qq = q1 * sA;
#pragma unroll
                for (int j = 0; j < 4; ++j) { const int r = 4 * g + j; hloc[r] = hloc[r] + pl[r] * hin; pl[r] = pl[r] * pin; } }
            if (hi == 0) { LAS float* sp2 = SUM + ((par * 8 + wave) * 32 + c) * 2; sp2[0] = cc; sp2[1] = qq; }
        }
        if (round + 1 < 8) LRU_LOADS(round + 1);
        LDS_WAIT(); __syncthreads();
        {
            float Rw = R, hin = 0.f;
#pragma unroll
            for (int w2 = 0; w2 < 8; ++w2) { const LAS float* sp2 = SUM + ((par * 8 + w2) * 32 + c) * 2; const float C = sp2[0], Q = sp2[1];
                if (w2 == wave) hin = Rw; Rw = Q * Rw + C; }
            R = Rw;
#pragma unroll
            for (int r = 0; r < 16; ++r) { const int tok = (r & 3) + 8 * (r >> 2) + 4 * hi;
                const float y = (hloc[r] + pl[r] * hin) * gg[r];
                CAT[(rowb + tok) * KCAT + ch] = (bf16)pg8::bf1(y); }
        }
    }
#undef LRU_LOADS
    __syncthreads();
}

__device__ __forceinline__ void ffn_fixup_item(const Ptrs& P, int l, int chunk, int tid) {
    unsigned char* ws = P.ws;
    const float* HALO = (const float*)(ws + WS_HALO); bf16* ACT = (bf16*)(ws + WS_ACT);
    const float* cw = P.ffn_conv_w + (size_t)l * 3 * NUP; const float* cb = P.ffn_conv_b + (size_t)l * NUP;
    const bool first = (chunk % 32) == 0;
    const size_t r0 = (size_t)chunk * 64;
    for (int ch = tid; ch < DFF; ch += 512) {
        float y[2][2];
#pragma unroll
        for (int hf = 0; hf < 2; ++hf) {
            const float* hc = HALO + ((size_t)(chunk * 4) * 2 + hf) * DFF + ch;
            const float u0 = hc[0], u1 = hc[2 * DFF];
            float um2 = 0.f, um1 = 0.f;
            if (!first) { const float* hpv = HALO + ((size_t)((chunk - 1) * 4) * 2 + hf) * DFF + ch; um2 = hpv[2 * 2 * DFF]; um1 = hpv[3 * 2 * DFF]; }
            const int cc = hf * DFF + ch;
            const float w0 = cw[cc], w1 = cw[NUP + cc], w2 = cw[2 * NUP + cc], bb = cb[cc];
            y[hf][0] = bb + w0 * um2 + w1 * um1 + w2 * u0;
            y[hf][1] = bb + w0 * um1 + w1 * u0 + w2 * u1;
        }
#pragma unroll
        for (int k = 0; k < 2; ++k) { const float yg = y[0][k]; ACT[(r0 + k) * DFF + ch] = (bf16)pg8::bf1(yg * __builtin_amdgcn_rcpf(1.0f + __expf(-yg)) * y[1][k]); }
    }
}

__device__ __forceinline__ void final_norm_rows(const Ptrs& P, int gw, int NGW, int lane) {
    const float* ssp = (const float*)(P.ws + WS_SSP);
    for (int m = gw; m < M; m += NGW) {
        const float rs = pg8::rstd4(ssp, m);
        f32x4* xr = (f32x4*)(P.out + (size_t)m * DM) + lane; const f32x4* gr = (const f32x4*)P.final_norm + lane;
#pragma unroll
        for (int j = 0; j < 4; ++j) { const f32x4 v = xr[64 * j], g = gr[64 * j]; xr[64 * j] = v * rs * g; }
    }
}
struct Args { const void* in[23]; float* out; unsigned char* ws; int ph_lo, ph_hi; };
__global__ void __launch_bounds__(NWAVES * 64, 2) trunk_fwd(Args args) {
    extern __shared__ __attribute__((aligned(16))) unsigned char lds_raw[];
    LAS unsigned char* lds = (LAS unsigned char*)lds_raw;
    const int tid = threadIdx.x, lane = tid & 63, wave = __builtin_amdgcn_readfirstlane(tid >> 6);
    const int G = gridDim.x, bx = blockIdx.x;
    const int vcu = (G % 8 == 0) ? (bx % 8) * (G / 8) + bx / 8 : bx;
    const int gw = vcu * NWAVES + wave, NGW = G * NWAVES;
    Ptrs P;
    P.x = (const float*)args.in[0]; P.mem = (const float*)args.in[1]; P.pos = (const int*)args.in[2]; P.norm_mix = (const float*)args.in[3]; P.norm_ffn = (const float*)args.in[4];
    P.mem_norm = (const float*)args.in[5]; P.final_norm = (const float*)args.in[6]; P.w_mem_kv = (const float*)args.in[7]; P.w_ffn_up = (const float*)args.in[8];
    P.ffn_conv_w = (const float*)args.in[9]; P.ffn_conv_b = (const float*)args.in[10]; P.w_ffn_down = (const float*)args.in[11]; P.lru_w_in = (const float*)args.in[12];
    P.lru_conv_w = (const float*)args.in[13]; P.lru_conv_b = (const float*)args.in[14]; P.lru_w_a = (const float*)args.in[15]; P.lru_b_a = (const float*)args.in[16];
    P.lru_w_x = (const float*)args.in[17]; P.lru_b_x = (const float*)args.in[18]; P.lru_lambda = (const float*)args.in[19]; P.lru_w_out = (const float*)args.in[20];
    P.dsa_w_in = (const float*)args.in[21]; P.dsa_w_out = (const float*)args.in[22]; P.out = args.out; P.ws = args.ws;
    unsigned char* ws = args.ws;
    for (int u = tid; u < (LDS_BYTES - LDSCTL_OFF) / 4; u += NWAVES * 64) ((LAS unsigned*)(lds + LDSCTL_OFF))[u] = 0u;
    __syncthreads();
    const int lo = args.ph_lo, hi = args.ph_hi;
    XcdBarrier bar; bar.bar = (unsigned*)(ws + WS_CTL) + CW_BAR; bar.x = 0; bar.st = nullptr;
    if (hi - lo > 1) bar = xcd_barrier_post((unsigned*)(ws + WS_CTL) + CW_BAR, (volatile LAS unsigned*)(lds + MISC_OFF) + 8);
#ifndef PH_MASK
#define PH_MASK 0x7fff
#endif
#define IN(k) ((((PH_MASK) >> (k)) & 1) && lo <= (k) && (k) < hi)
#ifdef PROBE_PHASE
    unsigned long long pr_last = __builtin_amdgcn_s_memrealtime(), pr_dt = 0;
#define SEAM(k) do { if (IN(k) && IN((k) + 1)) xcd_barrier(bar); { const unsigned long long now_ = __builtin_amdgcn_s_memrealtime(); if ((k) == PROBE_PHASE) pr_dt = now_ - pr_last; pr_last = now_; } } while (0)
#else
#define SEAM(k) do { if (IN(k) && IN((k) + 1)) xcd_barrier(bar); } while (0)
#endif
    float* ssp = (float*)(ws + WS_SSP);
    bf16* xb16 = (bf16*)(ws + WS_XB16);

    if (IN(0)) { int ln = lane; asm volatile("" : "+v"(ln)); p0_prologue(P, lds, gw, NGW, wave, ln); }
    SEAM(0);
    if (IN(1)) {
        { pg8::Gemm g{(const bf16*)(ws + WS_MEM16), (const bf16*)(ws + WS_WKV), MMEM, 2048, DM}; pg8::StaticOrder S; S.init(MMEM, 2048, G, (bx + G / 2) % G);
          pg8::EpiKV E{(const float*)(ws + WS_SSM), (bf16*)(ws + WS_MK), (bf16*)(ws + WS_MVT)};
          pg8::gemm_phase<pg8::EpiKV, pg8::StaticOrder, true, true>(lds + RING_OFF, g, S, E); }
        { pg8::Gemm g{xb16, (const bf16*)(ws + WS_WIN0), M, NIN0, DM}; pg8::StaticOrder S; S.init(M, NIN0, G, bx);
          pg8::EpiIn0 E{ssp, (bf16*)(ws + WS_XBR), (bf16*)(ws + WS_GBR), (bf16*)(ws + WS_CAT0)};
          pg8::gemm_phase<pg8::EpiIn0, pg8::StaticOrder, true, true>(lds + RING_OFF, g, S, E); }
    }
    SEAM(1);
    if (IN(2)) {
        int ln = lane, td = tid; asm volatile("" : "+v"(ln), "+v"(td));
        lru_item(P, lds, vcu >> 5, (vcu >> 1) & 15, vcu & 1, td, wave, ln);
        for (int u = vcu; u < 256; u += G) memattn_block(ws, lds, 0, (bf16*)(ws + WS_CAT0), u, td, wave, ln);
    }
    SEAM(2);
    if (IN(3)) { pg8::Gemm g{(const bf16*)(ws + WS_CAT0), (const bf16*)(ws + WS_WOUT0), M, DM, KCAT}; pg8::StaticOrder S; S.init(M, DM, G, bx);
        pg8::EpiOut E{P.x, P.out, xb16, ssp};
        pg8::gemm_phase<pg8::EpiOut, pg8::StaticOrder, false, true>(lds + RING_OFF, g, S, E); }
    SEAM(3);
    for (int l = 0; l < 2; ++l) {
        const int pb = l ? 11 : 4;
        if (l == 1) {
            if (IN(7)) { pg8::Gemm g{xb16, (const bf16*)(ws + WS_WIN1), M, NIN1, DM}; pg8::StaticOrder S; S.init(M, NIN1, G, bx);
                pg8::EpiIn1 E{ssp, (const float*)(ws + WS_COSA), (const float*)(ws + WS_SINA), (const float*)(ws + WS_COSI), (const float*)(ws + WS_SINI),
                              (bf16*)(ws + WS_CAT1), (bf16*)(ws + WS_KB), (bf16*)(ws + WS_VT), (bf16*)(ws + WS_IQ), (bf16*)(ws + WS_IK), (float*)(ws + WS_IW)};
                pg8::gemm_phase<pg8::EpiIn1, pg8::StaticOrder, true, true>(lds + RING_OFF, g, S, E); }
            SEAM(7);
            if (IN(8)) { int ln = lane, td = tid; asm volatile("" : "+v"(ln), "+v"(td));
                for (int u0 = vcu * 8; u0 < 2048; u0 += G * 8) { topk_block(ws, lds, u0, 0, td, wave, ln); topk_block(ws, lds, u0, 1, td, wave, ln); } }
            SEAM(8);
            if (IN(9)) { int ln = lane, td = tid; asm volatile("" : "+v"(ln), "+v"(td));
                for (int u = vcu; u < 256; u += G) { dsa_block(ws, lds, u, td, wave, ln); dsa_block(ws, lds, 511 - u, td, wave, ln); memattn_block(ws, lds, 1, (bf16*)(ws + WS_CAT1), u, td, wave, ln); } }
            SEAM(9);
            if (IN(10)) { pg8::Gemm g{(const bf16*)(ws + WS_CAT1), (const bf16*)(ws + WS_WOUT1), M, DM, KCAT}; pg8::StaticOrder S; S.init(M, DM, G, bx);
                pg8::EpiOut E{P.out, P.out, xb16, ssp};
                pg8::gemm_phase<pg8::EpiOut, pg8::StaticOrder, false, true>(lds + RING_OFF, g, S, E); }
            SEAM(10);
        }
        if (IN(pb)) { pg8::Gemm g{xb16, (const bf16*)(ws + (l ? WS_WUP1 : WS_WUP0)), M, NUP, DM}; pg8::StaticOrder S; S.init(M, NUP, G, bx);
            pg8::EpiUp E{ssp, P.ffn_conv_w + (size_t)l * 3 * NUP, P.ffn_conv_b + (size_t)l * NUP, (bf16*)(ws + WS_ACT), (float*)(ws + WS_HALO), (LAS float*)(lds + TOPK_IK_OFF)};
            pg8::gemm_phase<pg8::EpiUp, pg8::StaticOrder, true, true>(lds + RING_OFF, g, S, E); }
        SEAM(pb);
        if (IN(pb + 1)) { int td = tid; asm volatile("" : "+v"(td)); for (int ck = bx; ck < 256; ck += G) ffn_fixup_item(P, l, ck, td); }
        SEAM(pb + 1);
        if (IN(pb + 2)) { pg8::Gemm g{(const bf16*)(ws + WS_ACT), (const bf16*)(ws + (l ? WS_WDN1 : WS_WDN0)), M, DM, DFF}; pg8::StaticOrder S; S.init(M, DM, G, bx);
            pg8::EpiOut E{P.out, P.out, xb16, ssp};
            pg8::gemm_phase<pg8::EpiOut, pg8::StaticOrder, false, true>(lds + RING_OFF, g, S, E); }
        SEAM(pb + 2);
    }
    if (IN(14)) { int ln = lane; asm volatile("" : "+v"(ln)); final_norm_rows(P, gw, NGW, ln); }
#ifdef PROBE_PHASE
    { const unsigned long long now_ = __builtin_amdgcn_s_memrealtime(); if (14 == PROBE_PHASE) pr_dt = now_ - pr_last;
#ifdef PROBE_SUB
      pr_dt = *(volatile unsigned long long*)((unsigned long long*)(ws + WS_CTL + 32768) + PROBE_SUB);
#endif
      if (bx == 0 && wave == 0) { const unsigned long long tgt = now_ + PROBE_AMP * pr_dt; while (__builtin_amdgcn_s_memrealtime() < tgt) __builtin_amdgcn_s_sleep(32); } }
#endif
#undef IN
#undef SEAM
}

extern "C" void kernel_launch(void* const* d_in, const int* in_sizes, int n_in, void* d_out, int out_size, void* d_ws, size_t ws_size, hipStream_t stream) {
    static int grid = 0;
    if (grid == 0) {
        if (n_in != 23 || out_size != M * DM || ws_size < WS_END) { fprintf(stderr, "kernel_launch: unexpected problem shape (n_in %d out %d ws %zu)\n", n_in, out_size, ws_size); grid = -1; return; }
        int dev = 0, cus = 0;
        if (hipGetDevice(&dev) != hipSuccess || hipDeviceGetAttribute(&cus, hipDeviceAttributeMultiprocessorCount, dev) != hipSuccess) { grid = -1; return; }
        if (hipFuncSetAttribute((const void*)trunk_fwd, hipFuncAttributeMaxDynamicSharedMemorySize, LDS_BYTES) != hipSuccess) { fprintf(stderr, "kernel_launch: hipFuncSetAttribute failed\n"); grid = -1; return; }
        int per_cu = 0;
        if (hipOccupancyMaxActiveBlocksPerMultiprocessor(&per_cu, (const void*)trunk_fwd, NWAVES * 64, LDS_BYTES) != hipSuccess || per_cu < 1) fprintf(stderr, "kernel_launch: occupancy query says %d\n", per_cu);
        (void)hipGetLastError();
        grid = cus;
        if (grid != 256) { fprintf(stderr, "kernel_launch: built for 256 CUs, found %d\n", grid); grid = -1; return; }
    }
    if (grid < 0) return;
    if (hipMemsetAsync((char*)d_ws + WS_CTL, 0, CTL_ZERO_BYTES, stream) != hipSuccess) return;
    Args a{};
    for (int i = 0; i < 23; ++i) a.in[i] = d_in[i];
    a.out = (float*)d_out; a.ws = (unsigned char*)d_ws;
#if MK_N_LAUNCHES == 1
    a.ph_lo = 0; a.ph_hi = N_PHASES;
    hipLaunchKernelGGL(trunk_fwd, dim3(grid), dim3(NWAVES * 64), LDS_BYTES, stream, a);
#else
    for (int p = 0; p < N_PHASES; ++p) { a.ph_lo = p; a.ph_hi = p + 1; hipLaunchKernelGGL(trunk_fwd, dim3(grid), dim3(NWAVES * 64), LDS_BYTES, stream, a); }
#endif
}
```
